# Optimizing an MI355X kernel written in HIP

```python
import jax, jax.numpy as jnp
from jax import lax
import numpy as np

D_MODEL = 1024
BATCH = 2
SEQ = 8192
DEPTH = 1

CHUNK = 64
Q_BLOCK = 128
EPS = 1e-6

SB_HEADS = 8
SB_HEAD_DIM = 64
SB_WIDTH = SB_HEADS * SB_HEAD_DIM

MLA_HEADS = 8
MLA_NOPE_DIM = 64
MLA_ROPE_DIM = 32
MLA_V_DIM = 64
MLA_Q_LORA = 384
MLA_KV_LORA = 256
MLA_QK_DIM = MLA_NOPE_DIM + MLA_ROPE_DIM
MLA_WIDTH = MLA_HEADS * MLA_V_DIM
ROPE_THETA = 10000.0

N_BRANCH = 2
IN_SPLIT_SIZES = (SB_WIDTH, SB_WIDTH, SB_WIDTH, SB_WIDTH,
                  MLA_Q_LORA, MLA_KV_LORA, MLA_ROPE_DIM, MLA_WIDTH,
                  N_BRANCH * D_MODEL)
IN_COLS = sum(IN_SPLIT_SIZES)

kernel_name = "hybrid_stickbreaking_mla_gated_block"


def rmsnorm(x, g):
    x32 = x.astype(jnp.float32)
    inv = lax.rsqrt(jnp.mean(x32 * x32, axis=-1, keepdims=True) + EPS)
    return (x32 * inv).astype(x.dtype) * g


def rope_tables(seq_len):
    half = MLA_ROPE_DIM // 2
    inv_freq = ROPE_THETA ** (-jnp.arange(half, dtype=jnp.float32) / half)
    ang = jnp.arange(seq_len, dtype=jnp.float32)[:, None] * inv_freq[None, :]
    return jnp.cos(ang), jnp.sin(ang)


def apply_rope(x, cos, sin):
    half = x.shape[-1] // 2
    x32 = x.astype(jnp.float32)
    x1, x2 = x32[..., :half], x32[..., half:]
    c, s = cos[None, :, None, :], sin[None, :, None, :]
    return jnp.concatenate([x1 * c - x2 * s, x1 * s + x2 * c], axis=-1).astype(x.dtype)


def to_query_blocks(q):
    b, s, h, d = q.shape
    return q.reshape(b, s // Q_BLOCK, Q_BLOCK, h, d).transpose(1, 0, 3, 2, 4)


def from_query_blocks(o):
    nb, b, h, qb, d = o.shape
    return o.transpose(1, 0, 3, 2, 4).reshape(b, nb * qb, h, d)


def stick_breaking_attention(q, k, v):
    seq_len = q.shape[1]
    scale = q.shape[-1] ** -0.5
    key_pos = jnp.arange(seq_len)
    qb = to_query_blocks(q)

    def block(args):
        q_blk, i = args
        q_pos = i * Q_BLOCK + jnp.arange(Q_BLOCK)
        z = jnp.einsum("bhqd,bshd->bhqs", q_blk, k).astype(jnp.float32) * scale
        strict = key_pos[None, :] < q_pos[:, None]
        log_beta = jax.nn.log_sigmoid(z)
        log_1m = jnp.where(strict, jax.nn.log_sigmoid(-z), 0.0)
        later = lax.cumsum(log_1m, axis=3, reverse=True) - log_1m
        w = jnp.where(strict, jnp.exp(log_beta + later), 0.0)
        return jnp.einsum("bhqs,bshd->bhqd", w.astype(v.dtype), v)

    o = lax.map(block, (qb, jnp.arange(qb.shape[0])))
    return from_query_blocks(o)


def chunk_causal_softmax_attention(q, k, v):
    seq_len = q.shape[1]
    scale = q.shape[-1] ** -0.5
    key_chunk = jnp.arange(seq_len) // CHUNK
    qb = to_query_blocks(q)

    def block(args):
        q_blk, i = args
        q_chunk = (i * Q_BLOCK + jnp.arange(Q_BLOCK)) // CHUNK
        allowed = key_chunk[None, :] <= q_chunk[:, None]
        z = jnp.einsum("bhqd,bshd->bhqs", q_blk, k).astype(jnp.float32) * scale
        p = jax.nn.softmax(jnp.where(allowed, z, -jnp.inf), axis=-1)
        return jnp.einsum("bhqs,bshd->bhqd", p.astype(v.dtype), v)

    o = lax.map(block, (qb, jnp.arange(qb.shape[0])))
    return from_query_blocks(o)


def setup_inputs(seed: int = 0) -> dict:
    key = jax.random.key(seed)
    ks = jax.random.split(key, 16)
    f32 = jnp.float32

    def nrm(k, shape, fan_in):
        return jax.random.normal(k, shape, f32) * (fan_in ** -0.5)

    def gain(k, n):
        return 1.0 + 0.01 * jax.random.normal(k, (DEPTH, n), f32)

    return {
        "x": jax.random.normal(ks[0], (BATCH, SEQ, D_MODEL), f32),
        "norm_in_g": gain(ks[1], D_MODEL),
        "w_in": nrm(ks[2], (DEPTH, D_MODEL, IN_COLS), D_MODEL),
        "b_gate": 0.1 * jax.random.normal(ks[3], (DEPTH, N_BRANCH * D_MODEL), f32),
        "q_norm_g": gain(ks[4], MLA_Q_LORA),
        "w_q_up": nrm(ks[5], (DEPTH, MLA_Q_LORA, MLA_HEADS * MLA_QK_DIM), MLA_Q_LORA),
        "kv_norm_g": gain(ks[6], MLA_KV_LORA),
        "w_kv_up": nrm(ks[7], (DEPTH, MLA_KV_LORA, MLA_HEADS * (MLA_NOPE_DIM + MLA_V_DIM)), MLA_KV_LORA),
        "w_o_sb": nrm(ks[8], (DEPTH, SB_WIDTH, D_MODEL), SB_WIDTH),
        "w_o_mla": nrm(ks[9], (DEPTH, MLA_WIDTH, D_MODEL), MLA_WIDTH),
        "w_out": nrm(ks[10], (DEPTH, D_MODEL, D_MODEL), D_MODEL),
        "norm_f_g": 1.0 + 0.01 * jax.random.normal(ks[11], (D_MODEL,), f32),
    }


def reference(x, norm_in_g, w_in, b_gate, q_norm_g, w_q_up, kv_norm_g, w_kv_up,
              w_o_sb, w_o_mla, w_out, norm_f_g):
    b, s, _ = x.shape
    cos, sin = rope_tables(s)
    offsets = [int(o) for o in np.cumsum(IN_SPLIT_SIZES)[:-1]]

    for l in range(DEPTH):
        h = rmsnorm(x, norm_in_g[l])
        proj = jnp.einsum("bsd,de->bse", h, w_in[l])
        (q_sb, k_sb, v_sb, gate_sb, c_q, c_kv, k_rope,
         gate_mla, gate_logits) = jnp.split(proj, offsets, axis=-1)

        o_sb = stick_breaking_attention(
            q_sb.reshape(b, s, SB_HEADS, SB_HEAD_DIM),
            k_sb.reshape(b, s, SB_HEADS, SB_HEAD_DIM),
            v_sb.reshape(b, s, SB_HEADS, SB_HEAD_DIM)).reshape(b, s, SB_WIDTH)
        y_sb = jnp.einsum("bsc,cd->bsd", o_sb * jax.nn.silu(gate_sb), w_o_sb[l])

        q = jnp.einsum("bsr,re->bse", rmsnorm(c_q, q_norm_g[l]), w_q_up[l])
        q = q.reshape(b, s, MLA_HEADS, MLA_QK_DIM)
        q_nope, q_rope = q[..., :MLA_NOPE_DIM], q[..., MLA_NOPE_DIM:]
        q_rope = apply_rope(q_rope, cos, sin)
        kv = jnp.einsum("bsr,re->bse", rmsnorm(c_kv, kv_norm_g[l]), w_kv_up[l])
        kv = kv.reshape(b, s, MLA_HEADS, MLA_NOPE_DIM + MLA_V_DIM)
        k_nope, v_mla = kv[..., :MLA_NOPE_DIM], kv[..., MLA_NOPE_DIM:]
        k_rope = apply_rope(k_rope[:, :, None, :], cos, sin)
        q_full = jnp.concatenate([q_nope, q_rope], axis=-1)
        k_full = jnp.concatenate(
            [k_nope, jnp.broadcast_to(k_rope, (b, s, MLA_HEADS, MLA_ROPE_DIM))], axis=-1)
        o_mla = chunk_causal_softmax_attention(q_full, k_full, v_mla).reshape(b, s, MLA_WIDTH)
        y_mla = jnp.einsum("bsc,cd->bsd", o_mla * jax.nn.silu(gate_mla), w_o_mla[l])

        g = jax.nn.sigmoid(gate_logits + b_gate[l]).reshape(b, s, N_BRANCH, D_MODEL)
        merged = g[:, :, 0, :] * y_sb + g[:, :, 1, :] * y_mla
        x = x + jnp.einsum("bsd,de->bse", merged, w_out[l])

    return rmsnorm(x, norm_f_g)
```

```cpp
#include <hip/hip_runtime.h>
#include <hip/hip_cooperative_groups.h>
#include <cstdio>
#include <cstdint>
#include <cmath>
namespace cg = cooperative_groups;
namespace pg8 {
#define PG8_LAS __attribute__((address_space(3)))
typedef unsigned short bf16_t;
typedef short bf16x8 __attribute__((ext_vector_type(8)));
typedef float f32x4 __attribute__((ext_vector_type(4)));
typedef unsigned u32x4 __attribute__((ext_vector_type(4)));
constexpr int BM = 256, BK = 64, HALF = 128, HTB = HALF * BK * 2  , STAGE_BYTES = 8 * HTB, NXCD = 8, WGM = 8;

__host__ __device__ __forceinline__ int lds_byte(int r, int c) { const int st = (r >> 4) * 2 + (c >> 5), rr = r & 15, cc = c & 31, ob = rr * 64 + cc * 2; return st * 1024 + (ob ^ (((ob >> 9) & 1) << 5)); }
__host__ __device__ __forceinline__ void stage_rc(int b, int& R, int& C) { const int st = b / 1024, sb = b % 1024, swz = sb ^ (((sb >> 9) & 1) << 5); R = (st >> 1) * 16 + swz / 64; C = (st & 1) * 32 + (swz % 64) / 2; }
__host__ __device__ __forceinline__ int perm32(int rho) { const int n = rho >> 4, i = rho & 15; return 8 * (i >> 2) + 4 * n + (i & 3); }

struct Unit { int pm, pn; };
struct Gemm { const bf16_t* A; const bf16_t* Bt; int M, N, K; };

struct StaticOrder {
    int nM, nN, nwg, G, c;
    __host__ __device__ void init(int M, int N, int G_, int c_) { nM = M / BM; nN = N / BM; nwg = nM * nN; G = G_; c = c_; }
    __host__ __device__ bool next(int i, Unit& u) const {
        const long L = (long)i * G + c; if (L >= nwg) return false;
        int wgid = (int)L; { const int q = nwg / NXCD, r = nwg % NXCD, xcd = wgid % NXCD, off = wgid / NXCD; wgid = (xcd < r ? xcd * (q + 1) : r * (q + 1) + (xcd - r) * q) + off; }
        const int nig = WGM * nN, gid = wgid / nig, fm = gid * WGM, gsz = (nM - fm) < WGM ? (nM - fm) : WGM;
        u.pm = fm + ((wgid % nig) % gsz); u.pn = (wgid % nig) / gsz; return true;
    }
    __device__ __forceinline__ void a_ready(const Unit&) const {}
    __device__ __forceinline__ void done(const Unit&) const {}
};

typedef float f32x2_cv __attribute__((ext_vector_type(2))); typedef __bf16 bf16x2_cv __attribute__((ext_vector_type(2)));
__device__ __forceinline__ unsigned cvt_pk_bf16(float lo, float hi) { f32x2_cv v = {lo, hi}; bf16x2_cv b = __builtin_convertvector(v, bf16x2_cv); return __builtin_bit_cast(unsigned, b); }
typedef unsigned u32x2 __attribute__((ext_vector_type(2)));
__device__ __forceinline__ u32x4 pack8(f32x4 a, f32x4 b) { u32x4 w; w.x = cvt_pk_bf16(a[0], a[1]); w.y = cvt_pk_bf16(a[2], a[3]); w.z = cvt_pk_bf16(b[0], b[1]); w.w = cvt_pk_bf16(b[2], b[3]); return w; }
__device__ __forceinline__ u32x2 pack4(f32x4 a) { u32x2 w; w.x = cvt_pk_bf16(a[0], a[1]); w.y = cvt_pk_bf16(a[2], a[3]); return w; }
__device__ __forceinline__ void unpack8(u32x4 w, f32x4& a, f32x4& b) {
    a[0] = __uint_as_float(w.x << 16); a[1] = __uint_as_float(w.x & 0xffff0000u); a[2] = __uint_as_float(w.y << 16); a[3] = __uint_as_float(w.y & 0xffff0000u);
    b[0] = __uint_as_float(w.z << 16); b[1] = __uint_as_float(w.z & 0xffff0000u); b[2] = __uint_as_float(w.w << 16); b[3] = __uint_as_float(w.w & 0xffff0000u); }
__device__ __forceinline__ float sigmoid_fast(float v) { return __builtin_amdgcn_rcpf(1.0f + __builtin_amdgcn_exp2f(-1.4426950408889634f * v)); }

struct Epi1 {
    static constexpr bool PERM = true, AFTER_DRAIN = false, HAS_MID = false;
    bf16_t *Qsb, *Ksb, *Gsb, *Cq, *Ckv, *Gmla, *G; float* Krope; const float* bgate;
    template <int MODE> __device__ __forceinline__ void tile(const f32x4 (&acc)[2][2][4][2], bf16_t* base, int ld, int colt, float sc, int row0, int wc, int fq) const {
#pragma unroll
        for (int bj = 0; bj < 2; ++bj) { const int col = colt + bj * HALF + wc * 32 + 8 * fq;
            f32x4 b0 = (f32x4){0.f, 0.f, 0.f, 0.f}, b1 = b0;
#ifndef DBG_NOBIAS
            if (MODE == 2) { b0 = *(const f32x4*)(bgate + col); b1 = *(const f32x4*)(bgate + col + 4); }
#endif
#pragma unroll
            for (int ai = 0; ai < 2; ++ai)
#pragma unroll
                for (int m = 0; m < 4; ++m) { bf16_t* p = base + (size_t)(row0 + ai * HALF + m * 16) * ld + col;
                    f32x4 v0 = acc[ai][bj][m][0], v1 = acc[ai][bj][m][1];
                    if (MODE == 0) { v0 = v0 * sc; v1 = v1 * sc; }
                    else { v0 = v0 + b0; v1 = v1 + b1;
#pragma unroll
                        for (int e = 0; e < 4; ++e) { const float s0 = sigmoid_fast(v0[e]), s1 = sigmoid_fast(v1[e]); v0[e] = (MODE == 1) ? v0[e] * s0 : s0; v1[e] = (MODE == 1) ? v1[e] * s1 : s1; } }
                    *(u32x4*)p = pack8(v0, v1); } }
    }
    __device__ __forceinline__ void operator()(const f32x4 (&acc)[2][2][4][2], const Unit& u, int wr, int wc, int fr, int fq) const {
        asm volatile("" : "+v"(fr), "+v"(fq));
#ifdef DBG_ROT
        const int row0 = u.pm * BM + wr * 64 + fr, pn = (u.pn + 11) % 19;
#else
        const int row0 = u.pm * BM + wr * 64 + fr, pn = u.pn;
#endif
        if (pn < 2) tile<0>(acc, Qsb, 512, pn * 256, 0.125f, row0, wc, fq);
        else if (pn < 4) tile<0>(acc, Ksb, 512, (pn - 2) * 256, 1.f, row0, wc, fq);
        else if (pn < 6) tile<1>(acc, Gsb, 512, (pn - 4) * 256, 1.f, row0, wc, fq);
        else if (pn == 6) tile<0>(acc, Cq, 384, 0, 1.f, row0, wc, fq);
        else if (pn == 7) {
#pragma unroll
            for (int ai = 0; ai < 2; ++ai)
#pragma unroll
                for (int m = 0; m < 4; ++m) { const size_t row = (size_t)(row0 + ai * HALF + m * 16);
                    *(u32x4*)(Cq + row * 384 + 256 + wc * 32 + 8 * fq) = pack8(acc[ai][0][m][0], acc[ai][0][m][1]);
                    if (wc == 0) { float* kp = Krope + row * 32 + 8 * fq; *(f32x4*)kp = acc[ai][1][m][0]; *(f32x4*)(kp + 4) = acc[ai][1][m][1]; } }
        }
        else if (pn == 8) tile<0>(acc, Ckv, 256, 0, 1.f, row0, wc, fq);
        else if (pn < 11) tile<1>(acc, Gmla, 512, (pn - 9) * 256, 1.f, row0, wc, fq);
        else tile<2>(acc, G, 2048, (pn - 11) * 256, 1.f, row0, wc, fq);
    }
};
struct EpiPlain {
    static constexpr bool PERM = true, AFTER_DRAIN = false, HAS_MID = false;
    bf16_t* O; int ldc;
    __device__ __forceinline__ void operator()(const f32x4 (&acc)[2][2][4][2], const Unit& u, int wr, int wc, int fr, int fq) const {
        asm volatile("" : "+v"(fr), "+v"(fq));
        const int row0 = u.pm * BM + wr * 64 + fr, col0 = u.pn * BM + wc * 32 + 8 * fq;
#pragma unroll
        for (int ai = 0; ai < 2; ++ai)
#pragma unroll
            for (int m = 0; m < 4; ++m)
#pragma unroll
                for (int bj = 0; bj < 2; ++bj) *(u32x4*)(O + (size_t)(row0 + ai * HALF + m * 16) * ldc + col0 + bj * HALF) = pack8(acc[ai][bj][m][0], acc[ai][bj][m][1]);
    }
};
struct Epi2a {
    static constexpr bool PERM = true, AFTER_DRAIN = false, HAS_MID = false;
    bf16_t* Qm; const float* cosT; const float* sinT; float qs;
    __device__ __forceinline__ void operator()(const f32x4 (&acc)[2][2][4][2], const Unit& u, int wr, int wc, int fr, int fq) const {
        asm volatile("" : "+v"(fr), "+v"(fq));
        const int row0 = u.pm * BM + wr * 64 + fr;
        if (u.pn < 2) {
#pragma unroll
            for (int ai = 0; ai < 2; ++ai)
#pragma unroll
                for (int m = 0; m < 4; ++m) { const int row = row0 + ai * HALF + m * 16, b = row >> 13, s = row & 8191;
#pragma unroll
                    for (int bj = 0; bj < 2; ++bj) { const int col = u.pn * 256 + bj * HALF + wc * 32 + 8 * fq, h = col >> 6, d = col & 63;
                        *(u32x4*)(Qm + ((size_t)((b * 8 + h) * 8192 + s)) * 96 + d) = pack8(acc[ai][bj][m][0] * qs, acc[ai][bj][m][1] * qs); } }
        } else {
#pragma unroll
            for (int ai = 0; ai < 2; ++ai)
#pragma unroll
                for (int m = 0; m < 4; ++m) { const int row = row0 + ai * HALF + m * 16, b = row >> 13, s = row & 8191;
                    const f32x4 c4 = *(const f32x4*)(cosT + s * 16 + 4 * fq), s4 = *(const f32x4*)(sinT + s * 16 + 4 * fq);
#pragma unroll
                    for (int bj = 0; bj < 2; ++bj) { const int h = bj * 4 + wc; const f32x4 x1 = acc[ai][bj][m][0], x2 = acc[ai][bj][m][1];
                        const f32x4 o1 = (x1 * c4 - x2 * s4) * qs, o2 = (x1 * s4 + x2 * c4) * qs;
                        bf16_t* p = Qm + ((size_t)((b * 8 + h) * 8192 + s)) * 96 + 64 + 4 * fq;
                        *(u32x2*)p = pack4(o1); *(u32x2*)(p + 16) = pack4(o2); }
                    asm volatile("" ::: "memory"); }
        }
    }
};
struct Epi2b {
    static constexpr bool PERM = true, AFTER_DRAIN = false, HAS_MID = false;
    bf16_t* Km;
    __device__ __forceinline__ void operator()(const f32x4 (&acc)[2][2][4][2], const Unit& u, int wr, int wc, int fr, int fq) const {
        asm volatile("" : "+v"(fr), "+v"(fq));
        const int row0 = u.pm * BM + wr * 64 + fr;
#pragma unroll
        for (int ai = 0; ai < 2; ++ai)
#pragma unroll
            for (int m = 0; m < 4; ++m) { const int row = row0 + ai * HALF + m * 16, b = row >> 13, s = row & 8191;
#pragma unroll
                for (int bj = 0; bj < 2; ++bj) { const int col = u.pn * 256 + bj * HALF + wc * 32 + 8 * fq, h = col >> 6, d = col & 63;
                    *(u32x4*)(Km + ((size_t)((b * 8 + h) * 8192 + s)) * 96 + d) = pack8(acc[ai][bj][m][0], acc[ai][bj][m][1]); } }
    }
};
struct Epi4 {
    static constexpr bool PERM = true, AFTER_DRAIN = false, HAS_MID = true;
    const bf16_t* G; bf16_t* Mg;
    __device__ __forceinline__ void mid(f32x4 (&acc)[2][2][4][2], const Unit& u, int wr, int wc, int fr, int fq) const {
        asm volatile("" : "+v"(fr), "+v"(fq));
        const int row0 = u.pm * BM + wr * 64 + fr, col0 = u.pn * BM + wc * 32 + 8 * fq;
#pragma unroll
        for (int ai = 0; ai < 2; ++ai)
#pragma unroll
            for (int m = 0; m < 4; ++m)
#pragma unroll
                for (int bj = 0; bj < 2; ++bj) { const bf16_t* gp = G + (size_t)(row0 + ai * HALF + m * 16) * 2048 + col0 + bj * HALF;
                    f32x4 a0, a1, m0, m1; unpack8(*(const u32x4*)gp, a0, a1); unpack8(*(const u32x4*)(gp + 1024), m0, m1);
#pragma unroll
                    for (int e = 0; e < 4; ++e) { acc[ai][bj][m][0][e] *= a0[e] * __builtin_amdgcn_rcpf(fmaxf(m0[e], 1e-20f)); acc[ai][bj][m][1][e] *= a1[e] * __builtin_amdgcn_rcpf(fmaxf(m1[e], 1e-20f)); } }
    }
    __device__ __forceinline__ void operator()(const f32x4 (&acc)[2][2][4][2], const Unit& u, int wr, int wc, int fr, int fq) const {
        asm volatile("" : "+v"(fr), "+v"(fq));
        const int row0 = u.pm * BM + wr * 64 + fr, col0 = u.pn * BM + wc * 32 + 8 * fq;
#pragma unroll
        for (int ai = 0; ai < 2; ++ai)
#pragma unroll
            for (int m = 0; m < 4; ++m)
#pragma unroll
                for (int bj = 0; bj < 2; ++bj) { const size_t row = (size_t)(row0 + ai * HALF + m * 16); const int col = col0 + bj * HALF;
                    f32x4 m0, m1; unpack8(*(const u32x4*)(G + row * 2048 + 1024 + col), m0, m1);
                    f32x4 v0 = acc[ai][bj][m][0], v1 = acc[ai][bj][m][1];
#pragma unroll
                    for (int e = 0; e < 4; ++e) { v0[e] *= fmaxf(m0[e], 1e-20f); v1[e] *= fmaxf(m1[e], 1e-20f); }
                    *(u32x4*)(Mg + row * 1024 + col) = pack8(v0, v1); }
    }
};
struct Epi5 {
    static constexpr bool PERM = true, AFTER_DRAIN = false, HAS_MID = false;
    const float* X; float* Out; float* rowsq;
    __device__ __forceinline__ void operator()(const f32x4 (&acc)[2][2][4][2], const Unit& u, int wr, int wc, int fr, int fq) const {
        asm volatile("" : "+v"(fr), "+v"(fq));
        const int row0 = u.pm * BM + wr * 64 + fr, col0 = u.pn * BM + wc * 32 + 8 * fq;
#pragma unroll
        for (int ai = 0; ai < 2; ++ai)
#pragma unroll
            for (int m = 0; m < 4; ++m) { const size_t row = (size_t)(row0 + ai * HALF + m * 16); float ss = 0.f;
#pragma unroll
                for (int bj = 0; bj < 2; ++bj) { const size_t off = row * 1024 + col0 + bj * HALF;
                    const f32x4 v0 = *(const f32x4*)(X + off) + acc[ai][bj][m][0], v1 = *(const f32x4*)(X + off + 4) + acc[ai][bj][m][1];
                    *(f32x4*)(Out + off) = v0; *(f32x4*)(Out + off + 4) = v1;
                    ss += (v0[0] * v0[0] + v0[1] * v0[1]) + (v0[2] * v0[2] + v0[3] * v0[3]) + (v1[0] * v1[0] + v1[1] * v1[1]) + (v1[2] * v1[2] + v1[3] * v1[3]); }
                ss += __shfl_xor(ss, 16); ss += __shfl_xor(ss, 32);
                if (fq == 0) atomicAdd(rowsq + row, ss); }
    }
};

template <class Epi, class Sched, bool ALIGN_EPI = false, bool SP2 = false>
__device__ __forceinline__ void gemm_phase(PG8_LAS unsigned char* lds, const Gemm g, const Sched& S, const Epi& E) {
    const int tid = threadIdx.x, wid = __builtin_amdgcn_readfirstlane(tid >> 6), lane = tid & 63, wr = wid >> 2, wc = wid & 3, fr = lane & 15, fq = lane >> 4;
    int K = g.K; asm volatile("" : "+s"(K));
    const int nt = K / BK;
    unsigned voffA[2], voffB[2];
#pragma unroll
    for (int i = 0; i < 2; ++i) { int R, C; stage_rc(tid * 16 + i * 8192, R, C); const int Rb = Epi::PERM ? ((R & ~31) + perm32(R & 31)) : R;
        voffA[i] = (unsigned)(R * K + C) * 2u; voffB[i] = (unsigned)(Rb * K + C) * 2u; }
    const size_t kstep = (size_t)(BK * 2);
    const size_t hstep = (size_t)HALF * K * 2;
    const size_t tstep = 2 * hstep;
    const unsigned ldsw = (unsigned)wid * 1024u;
    const int aoff = lds_byte(wr * 64 + fr, fq * 8), boff = lds_byte(wc * 32 + fr, fq * 8);
#define PG8_SA(b, h) (((b) * 2 + (h)) * HTB)
#define PG8_SB(b, h) ((4 + (b) * 2 + (h)) * HTB)
#define PG8_STAGE(bufoff, gbase, voff) do { _Pragma("unroll") for (int _i = 0; _i < 2; ++_i) \
        __builtin_amdgcn_global_load_lds((const unsigned*)((const char*)(gbase) + (voff)[_i]), (PG8_LAS unsigned*)(lds + (bufoff) + ldsw + _i * 8192), 16, 0, 0); } while (0)
#define PG8_LDA(dst, b, h) do { _Pragma("unroll") for (int m = 0; m < 4; ++m) _Pragma("unroll") for (int k = 0; k < 2; ++k) dst[m][k] = *(const PG8_LAS bf16x8*)(lds + PG8_SA(b, h) + aoff + m * 2048 + k * 1024); } while (0)
#define PG8_LDB(dst, b, h) do { _Pragma("unroll") for (int n = 0; n < 2; ++n) _Pragma("unroll") for (int k = 0; k < 2; ++k) dst[n][k] = *(const PG8_LAS bf16x8*)(lds + PG8_SB(b, h) + boff + n * 2048 + k * 1024); } while (0)
#define PG8_MMA(ai, bj, At, Bt) do { __builtin_amdgcn_s_setprio(1); _Pragma("unroll") for (int m = 0; m < 4; ++m) _Pragma("unroll") for (int n = 0; n < 2; ++n) _Pragma("unroll") for (int k = 0; k < 2; ++k) \
        acc[ai][bj][m][n] = __builtin_amdgcn_mfma_f32_16x16x32_bf16(Bt[n][k], At[m][k], acc[ai][bj][m][n], 0, 0, 0); __builtin_amdgcn_s_setprio(0); } while (0)
#define PG8_WAIT_V(n) asm volatile("s_waitcnt vmcnt(" #n ")" ::: "memory")
#define PG8_WAIT_L(n) asm volatile("s_waitcnt lgkmcnt(" #n ")" ::: "memory")
#define PG8_BAR __builtin_amdgcn_s_barrier()
#define PG8_SCHED __builtin_amdgcn_sched_barrier(0)
    Unit cur, nxt; int ui = 0;
    if (!S.next(0, cur)) return;
    f32x4 acc[2][2][4][2];
#pragma unroll
    for (int a = 0; a < 2; ++a)
#pragma unroll
        for (int b = 0; b < 2; ++b)
#pragma unroll
            for (int m = 0; m < 4; ++m)
#pragma unroll
                for (int n = 0; n < 2; ++n) acc[a][b][m][n] = (f32x4){0.f, 0.f, 0.f, 0.f};
    bf16x8 At[4][2], B0[2][2], B1[2][2];
    const char* cA = (const char*)g.A + (size_t)cur.pm * tstep; const char* cB = (const char*)g.Bt + (size_t)cur.pn * tstep;
    S.a_ready(cur);
    if constexpr (SP2) {
        PG8_STAGE(PG8_SB(0, 0), cB, voffB); PG8_STAGE(PG8_SB(0, 1), cB + hstep, voffB); PG8_STAGE(PG8_SA(0, 0), cA, voffA); PG8_STAGE(PG8_SA(0, 1), cA + hstep, voffA);
        if (wr == 1) PG8_BAR;
        PG8_WAIT_V(2); PG8_BAR;
        PG8_STAGE(PG8_SB(1, 0), cB + kstep, voffB); PG8_STAGE(PG8_SA(1, 0), cA + kstep, voffA); PG8_STAGE(PG8_SB(1, 1), cB + hstep + kstep, voffB);
        PG8_WAIT_V(6); PG8_BAR;
    } else {
        PG8_STAGE(PG8_SB(0, 0), cB, voffB); PG8_STAGE(PG8_SA(0, 0), cA, voffA); PG8_STAGE(PG8_SB(0, 1), cB + hstep, voffB); PG8_STAGE(PG8_SA(0, 1), cA + hstep, voffA);
        if (wr == 1) PG8_BAR;
        PG8_WAIT_V(4); PG8_BAR;
        PG8_STAGE(PG8_SB(1, 0), cB + kstep, voffB); PG8_STAGE(PG8_SA(1, 0), cA + kstep, voffA); PG8_STAGE(PG8_SB(1, 1), cB + hstep + kstep, voffB);
        PG8_WAIT_V(6); PG8_BAR;
    }
    for (;;) {
        const bool has_next = S.next(ui + 1, nxt);
        const char* nA = has_next ? (const char*)g.A + (size_t)nxt.pm * tstep : cA; const char* nB = has_next ? (const char*)g.Bt + (size_t)nxt.pn * tstep : cB;
        for (int t = 0; t < nt; t += 2) {
            if constexpr (Epi::HAS_MID) { if (t == nt / 2) E.mid(acc, cur, wr, wc, fr, fq); }
            const bool last = (t == nt - 2);
            const char* a1 = cA + (size_t)(t + 1) * kstep;
            const char* a2 = last ? nA : cA + (size_t)(t + 2) * kstep; const char* b2 = last ? nB : cB + (size_t)(t + 2) * kstep;
            const char* a3 = a2 + kstep; const char* b3 = b2 + kstep;
            if (last && has_next) S.a_ready(nxt);
            if constexpr (SP2) {
            PG8_LDB(B0, 0, 0); PG8_LDB(B1, 0, 1); PG8_SCHED; PG8_LDA(At, 0, 0); PG8_STAGE(PG8_SA(1, 1), a1 + hstep, voffA);
            PG8_WAIT_V(8); PG8_WAIT_L(0); PG8_BAR; PG8_MMA(0, 0, At, B0); PG8_MMA(0, 1, At, B1); PG8_BAR; PG8_SCHED;
            PG8_LDA(At, 0, 1); PG8_STAGE(PG8_SB(0, 0), b2, voffB); PG8_STAGE(PG8_SB(0, 1), b2 + hstep, voffB); PG8_STAGE(PG8_SA(0, 0), a2, voffA);
            PG8_WAIT_V(8); PG8_WAIT_L(0); PG8_BAR; PG8_MMA(1, 0, At, B0); PG8_MMA(1, 1, At, B1); PG8_BAR; PG8_SCHED;
            PG8_LDB(B0, 1, 0); PG8_LDB(B1, 1, 1); PG8_SCHED; PG8_LDA(At, 1, 0); PG8_STAGE(PG8_SA(0, 1), a2 + hstep, voffA);
            PG8_WAIT_V(8); PG8_WAIT_L(0); PG8_BAR; PG8_MMA(0, 0, At, B0); PG8_MMA(0, 1, At, B1); PG8_BAR; PG8_SCHED;
            PG8_LDA(At, 1, 1); PG8_STAGE(PG8_SB(1, 0), b3, voffB); PG8_STAGE(PG8_SB(1, 1), b3 + hstep, voffB); PG8_STAGE(PG8_SA(1, 0), a3, voffA);
            PG8_WAIT_V(8); PG8_WAIT_L(0); PG8_BAR; PG8_MMA(1, 0, At, B0); PG8_MMA(1, 1, At, B1); PG8_BAR; PG8_SCHED;
            } else {
            PG8_LDB(B0, 0, 0); PG8_SCHED; PG8_LDA(At, 0, 0); PG8_STAGE(PG8_SA(1, 1), a1 + hstep, voffA);
            PG8_WAIT_L(8); PG8_BAR; PG8_WAIT_L(0); PG8_MMA(0, 0, At, B0); PG8_BAR; PG8_SCHED;
            PG8_LDB(B1, 0, 1); PG8_STAGE(PG8_SB(0, 0), b2, voffB);
            PG8_BAR; PG8_WAIT_L(0); PG8_MMA(0, 1, At, B1); PG8_BAR;
            PG8_LDA(At, 0, 1); PG8_STAGE(PG8_SA(0, 0), a2, voffA);
            PG8_BAR; PG8_WAIT_L(0); PG8_MMA(1, 0, At, B0); PG8_BAR; PG8_SCHED;
            PG8_STAGE(PG8_SB(0, 1), b2 + hstep, voffB);
            PG8_WAIT_V(6); PG8_BAR; PG8_MMA(1, 1, At, B1); PG8_BAR;
            PG8_LDB(B0, 1, 0); PG8_SCHED; PG8_LDA(At, 1, 0); PG8_STAGE(PG8_SA(0, 1), a2 + hstep, voffA);
            PG8_WAIT_L(8); PG8_BAR; PG8_WAIT_L(0); PG8_MMA(0, 0, At, B0); PG8_BAR; PG8_SCHED;
            PG8_LDB(B1, 1, 1); PG8_STAGE(PG8_SB(1, 0), b3, voffB);
            PG8_BAR; PG8_WAIT_L(0); PG8_MMA(0, 1, At, B1); PG8_BAR;
            PG8_LDA(At, 1, 1); PG8_STAGE(PG8_SA(1, 0), a3, voffA);
            PG8_BAR; PG8_WAIT_L(0); PG8_MMA(1, 0, At, B0); PG8_BAR; PG8_SCHED;
            PG8_STAGE(PG8_SB(1, 1), b3 + hstep, voffB);
            PG8_WAIT_V(6); PG8_BAR; PG8_MMA(1, 1, At, B1); PG8_BAR;
            }
        }
        if constexpr (ALIGN_EPI) { if (wr == 0) PG8_BAR; }
        if constexpr (!Epi::AFTER_DRAIN) { E(acc, cur, wr, wc, fr, fq); S.done(cur); }
        if (!has_next) break;
#pragma unroll
        for (int a = 0; a < 2; ++a)
#pragma unroll
            for (int b = 0; b < 2; ++b)
#pragma unroll
                for (int m = 0; m < 4; ++m)
#pragma unroll
                    for (int n = 0; n < 2; ++n) acc[a][b][m][n] = (f32x4){0.f, 0.f, 0.f, 0.f};
        cur = nxt; cA = nA; cB = nB; ++ui;
        if constexpr (ALIGN_EPI) { if (wr == 1) PG8_BAR; }
    }
    PG8_WAIT_V(0);
    if constexpr (!ALIGN_EPI) { if (wr == 0) PG8_BAR; }
    PG8_BAR;
    if constexpr (Epi::AFTER_DRAIN) { E.fused(acc, cur, wr, wc, fr, fq, lds, wid, lane); S.done(cur); }
#undef PG8_SA
#undef PG8_SB
#undef PG8_STAGE
#undef PG8_LDA
#undef PG8_LDB
#undef PG8_MMA
#undef PG8_WAIT_V
#undef PG8_WAIT_L
#undef PG8_BAR
#undef PG8_SCHED
}
}

#define LAS __attribute__((address_space(3)))
typedef unsigned short bf16;
typedef short bf16x8 __attribute__((ext_vector_type(8)));
typedef float f32x4 __attribute__((ext_vector_type(4)));
typedef float f32x2 __attribute__((ext_vector_type(2)));
typedef float f32x16 __attribute__((ext_vector_type(16)));
typedef unsigned u32x4 __attribute__((ext_vector_type(4)));
typedef unsigned u32x2 __attribute__((ext_vector_type(2)));

constexpr int NWAVES = 8, NTHREADS = 512;
constexpr int BATCH = 2, SEQ = 8192, DM = 1024, M = BATCH * SEQ;
constexpr int IN_COLS = 5280;
constexpr float EPS = 1e-6f;
constexpr float L2E = 1.4426950408889634f;
constexpr int LDS_BYTES = 147456;
#ifndef MK_N_LAUNCHES
#define MK_N_LAUNCHES 1
#endif
constexpr int N_PHASES = 8;

constexpr size_t MiB = 1u << 20;
constexpr size_t KiB = 1u << 10;
constexpr size_t WS_ROWSQ = 0, WS_BT4 = 1 * MiB, WS_BT5 = 3 * MiB, WS_COS = 5 * MiB, WS_SIN = 5 * MiB + 512 * KiB;
constexpr size_t WS_BT2A = 6 * MiB, WS_BT2B = 6 * MiB + 768 * KiB, WS_BT2C = 7 * MiB, WS_KROPE = 7 * MiB + 256 * KiB;
constexpr size_t WS_G = 10 * MiB;
constexpr size_t WS_QSB = 74 * MiB, WS_KSB = 90 * MiB, WS_VTSB = 106 * MiB, WS_GSB = 122 * MiB, WS_GMLA = 138 * MiB;
constexpr size_t WS_MERGED = 74 * MiB;
constexpr size_t WS_KM = 154 * MiB, WS_QM = 178 * MiB, WS_VTM = 202 * MiB, WS_ACAT = 218 * MiB;
constexpr size_t WS_BT1 = 154 * MiB;
constexpr size_t WS_CQ = 178 * MiB, WS_CKV = 190 * MiB;
constexpr size_t WS_H = 218 * MiB;
constexpr size_t WS_CQN = 218 * MiB, WS_CKVN = 230 * MiB;
constexpr size_t WS_END = 256 * MiB;
constexpr int N1A = 4864, N1 = 5376;

__device__ __forceinline__ float wave_sum(float v) {
#pragma unroll
    for (int o = 1; o < 64; o <<= 1) v += __shfl_xor(v, o);
    return v;
}
__device__ __forceinline__ unsigned cvtpk(float lo, float hi) { return pg8::cvt_pk_bf16(lo, hi); }
__device__ __forceinline__ float bflo(unsigned w) { return __uint_as_float(w << 16); }
__device__ __forceinline__ float bfhi(unsigned w) { return __uint_as_float(w & 0xffff0000u); }

__device__ __forceinline__ int map_w_in(int n) {
    if (n >= N1A) return 1024 + (n - N1A);
#ifdef DBG_ROT
    const int t = ((n >> 8) + 11) % 19, w = n & 255; n = t * 256 + w;
#else
    const int t = n >> 8, w = n & 255;
#endif
    if (t < 4) return n;
    if (t < 6) return 1536 + (n - 1024);
    if (t == 6) return 2048 + w;
    if (t == 7) return w < 128 ? 2304 + w : (w < 160 ? 2688 + (w - 128) : -1);
    if (t == 8) return 2432 + w;
    if (t < 11) return 2720 + (n - 9 * 256);
    return 3232 + (n - 11 * 256);
}
__device__ __forceinline__ int map_q_up(int n) {
    if (n < 512) return (n >> 6) * 96 + (n & 63);
    const int r = n - 512, h = r >> 5, p = r & 31, fq = p >> 3, half = (p >> 2) & 1, i = p & 3;
    return h * 96 + 64 + half * 16 + 4 * fq + i;
}
template <int MAP> __device__ __forceinline__ void p0_transpose_item(const float* W, int Nsrc, bf16* WT, int kpitch, int koff, int nblk, LAS float* scr, int item, int lane) {
    const int kb = item / nblk, nb = item % nblk, k0 = 64 * kb, n0 = 32 * nb;
    const int n = n0 + (lane & 31);
    int src;
    if (MAP == 0) src = n; else if (MAP == 1) src = map_w_in(n); else if (MAP == 2) src = map_q_up(n); else if (MAP == 3) src = (n >> 6) * 128 + (n & 63); else src = (n >> 6) * 128 + 64 + (n & 63);
#pragma unroll 8
    for (int i = 0; i < 32; ++i) { const int kk = 2 * i + (lane >> 5); scr[kk * 33 + (lane & 31)] = src >= 0 ? W[(size_t)(k0 + kk) * Nsrc + src] : 0.f; }
    asm volatile("s_waitcnt lgkmcnt(0)" ::: "memory");
    const int c = lane & 7;
#pragma unroll
    for (int j = 0; j < 4; ++j) { const int nn = (lane >> 3) + 8 * j; const LAS float* s = scr + (8 * c) * 33 + nn;
        u32x4 o; o.x = cvtpk(s[0 * 33], s[1 * 33]); o.y = cvtpk(s[2 * 33], s[3 * 33]); o.z = cvtpk(s[4 * 33], s[5 * 33]); o.w = cvtpk(s[6 * 33], s[7 * 33]);
        *(u32x4*)(WT + (size_t)(n0 + nn) * kpitch + koff + k0 + 8 * c) = o; }
    asm volatile("s_waitcnt lgkmcnt(0)" ::: "memory");
}

__device__ __forceinline__ int swap23(int m) { return (m & ~12) | ((m & 4) << 1) | ((m & 8) >> 1); }
__device__ __forceinline__ void sb_task(int b, int h, int j, const bf16* __restrict__ Qsb, const bf16* __restrict__ Ksb, const bf16* __restrict__ Vt, const bf16* __restrict__ Gsb, bf16* __restrict__ Acat, int lane) {
    const int q = lane & 31, hi = lane >> 5, q0 = 32 * j, qpos = q0 + q;
    const size_t tokbase = (size_t)b * SEQ;
    bf16x8 qf[4];
    { const bf16* qp = Qsb + (tokbase + q0 + q) * 512 + h * 64 + hi * 8;
#pragma unroll
      for (int d0 = 0; d0 < 4; ++d0) qf[d0] = *(const bf16x8*)(qp + d0 * 16); }
    f32x16 o[2]; o[0] = f32x16{}; o[1] = f32x16{};
    float carry = 0.f;
    const int krow = swap23(q);
    for (int kt = j >> 1; kt >= 0; --kt) {
        const int key0 = kt * 64;
        const bool diag = (kt == (j >> 1));
        const bf16* kp = Ksb + (tokbase + key0 + krow) * 512 + h * 64 + hi * 8;
        bf16x8 kf[2][4];
#pragma unroll
        for (int blk = 0; blk < 2; ++blk)
#pragma unroll
            for (int d0 = 0; d0 < 4; ++d0) kf[blk][d0] = *(const bf16x8*)(kp + (size_t)blk * 32 * 512 + d0 * 16);
        const bf16* vp = Vt + (size_t)(h * 64 + q) * M + tokbase + key0 + 8 * hi;
        bf16x8 vf[2][4];
#pragma unroll
        for (int db = 0; db < 2; ++db)
#pragma unroll
            for (int g = 0; g < 4; ++g) vf[db][g] = *(const bf16x8*)(vp + (size_t)db * 32 * M + g * 16);
        f32x16 s[2]; s[0] = f32x16{}; s[1] = f32x16{};
#pragma unroll
        for (int d0 = 0; d0 < 4; ++d0) { s[0] = __builtin_amdgcn_mfma_f32_32x32x16_bf16(kf[0][d0], qf[d0], s[0], 0, 0, 0); s[1] = __builtin_amdgcn_mfma_f32_32x32x16_bf16(kf[1][d0], qf[d0], s[1], 0, 0, 0); }
        float T[4];
#pragma unroll
        for (int rho = 0; rho < 4; ++rho) {
            float run = 0.f;
#pragma unroll
            for (int i = 7; i >= 0; --i) {
                const int r = 8 * (rho & 1) + i;
                const float z = s[rho >> 1][r] * L2E;
                const float t = __builtin_amdgcn_exp2f(-fabsf(z));
                const float L = __builtin_amdgcn_logf(1.0f + t);
                float lb = fminf(z, 0.f) - L, l1 = fminf(-z, 0.f) - L;
                if (diag) { const int key = key0 + 32 * (rho >> 1) + 16 * (rho & 1) + 8 * hi + i; const bool strict = key < qpos; l1 = strict ? l1 : 0.f; lb = strict ? lb : -INFINITY; }
                s[rho >> 1][r] = lb + run;
                run += l1;
            }
            T[rho] = run;
        }
        float P[4];
#pragma unroll
        for (int rho = 0; rho < 4; ++rho) P[rho] = __shfl_xor(T[rho], 32);
        const float t3 = T[3] + P[3], t2 = T[2] + P[2], t1 = T[1] + P[1], t0 = T[0] + P[0];
        float E[4]; E[3] = 0.f; E[2] = t3; E[1] = t3 + t2; E[0] = E[1] + t1;
        const float tot = E[0] + t0;
#pragma unroll
        for (int rho = 0; rho < 4; ++rho) E[rho] += carry + (hi == 0 ? P[rho] : 0.f);
        carry += tot;
#pragma unroll
        for (int rho = 0; rho < 4; ++rho)
#pragma unroll
            for (int i = 0; i < 8; ++i) { const int r = 8 * (rho & 1) + i; s[rho >> 1][r] = __builtin_amdgcn_exp2f(s[rho >> 1][r] + E[rho]); }
#pragma unroll
        for (int g = 0; g < 4; ++g) { const int blk = g >> 1, r0 = 8 * (g & 1);
            u32x4 pw; pw.x = cvtpk(s[blk][r0], s[blk][r0 + 1]); pw.y = cvtpk(s[blk][r0 + 2], s[blk][r0 + 3]); pw.z = cvtpk(s[blk][r0 + 4], s[blk][r0 + 5]); pw.w = cvtpk(s[blk][r0 + 6], s[blk][r0 + 7]);
            const bf16x8 pf = __builtin_bit_cast(bf16x8, pw);
            o[0] = __builtin_amdgcn_mfma_f32_32x32x16_bf16(vf[0][g], pf, o[0], 0, 0, 0);
            o[1] = __builtin_amdgcn_mfma_f32_32x32x16_bf16(vf[1][g], pf, o[1], 0, 0, 0); }
        if (__all(carry < -160.f)) break;
    }
    const size_t tok = tokbase + qpos;
#pragma unroll
    for (int db = 0; db < 2; ++db)
#pragma unroll
        for (int c = 0; c < 4; ++c) { const int d = 32 * db + 8 * c + 4 * hi;
            const u32x2 g = *(const u32x2*)(Gsb + tok * 512 + h * 64 + d);
            u32x2 w; w.x = cvtpk(o[db][4 * c] * bflo(g.x), o[db][4 * c + 1] * bfhi(g.x)); w.y = cvtpk(o[db][4 * c + 2] * bflo(g.y), o[db][4 * c + 3] * bfhi(g.y));
            *(u32x2*)(Acat + tok * 1024 + h * 64 + d) = w; }
}

constexpr int MLA_KPITCH = 208, MLA_VPITCH = 144, MLA_KBUF = 64 * MLA_KPITCH, MLA_VBUF = 64 * MLA_VPITCH, MLA_VOFF = 2 * MLA_KBUF;
__device__ __forceinline__ void mla_unit(int b, int h, int qb, const bf16* __restrict__ Qm, const bf16* __restrict__ Km, const bf16* __restrict__ Vt, const bf16* __restrict__ Gm, bf16* __restrict__ Acat, LAS unsigned char* lds) {
    const int tid = threadIdx.x, lane = tid & 63, wid = __builtin_amdgcn_readfirstlane(tid >> 6), q = lane & 31, hi = lane >> 5;
    const int q0 = qb * 256 + wid * 32;
    const size_t tokbase = (size_t)b * SEQ;
    const bf16* Qbh = Qm + (size_t)((b * 8 + h) * SEQ) * 96;
    const char* Kbh = (const char*)(Km + (size_t)((b * 8 + h) * SEQ) * 96);
    const char* Vbh = (const char*)(Vt + (size_t)(h * 64) * M + tokbase);
    bf16x8 qf[6];
#pragma unroll
    for (int d0 = 0; d0 < 6; ++d0) qf[d0] = *(const bf16x8*)(Qbh + (size_t)(q0 + q) * 96 + d0 * 16 + hi * 8);
    const int NT = 4 * qb + 4, NTw = 4 * qb + (wid >> 1) + 1;
    const int kc0 = tid, kc1 = 512 + tid;
    const int klds0 = (kc0 / 12) * MLA_KPITCH + (kc0 % 12) * 16, klds1 = (kc1 / 12) * MLA_KPITCH + (kc1 % 12) * 16;
    const int vrow = tid >> 3, vc16 = tid & 7;
    const int vlds = MLA_VOFF + vrow * MLA_VPITCH + vc16 * 16;
    const char* vsrc = Vbh + (size_t)vrow * M * 2 + vc16 * 16;
    const bool k1 = tid < 256;
    u32x4 rk0, rk1 = (u32x4){0u, 0u, 0u, 0u}, rv;
    rk0 = *(const u32x4*)(Kbh + kc0 * 16); if (k1) rk1 = *(const u32x4*)(Kbh + kc1 * 16); rv = *(const u32x4*)(vsrc);
    *(LAS u32x4*)(lds + klds0) = rk0; if (k1) *(LAS u32x4*)(lds + klds1) = rk1; *(LAS u32x4*)(lds + vlds) = rv;
    __syncthreads();
    const int krd = swap23(q) * MLA_KPITCH + hi * 16;
    const int vrd = MLA_VOFF + q * MLA_VPITCH + hi * 16;
    f32x16 o[2]; o[0] = f32x16{}; o[1] = f32x16{};
    float mrun = -1e30f, lrun = 0.f;
    for (int t = 0; t < NT; ++t) {
        const int cur = t & 1, nxt = cur ^ 1;
        const bool more = (t + 1 < NT);
        if (more) { const char* kg = Kbh + (size_t)(t + 1) * 64 * 192; rk0 = *(const u32x4*)(kg + kc0 * 16); if (k1) rk1 = *(const u32x4*)(kg + kc1 * 16); rv = *(const u32x4*)(vsrc + (size_t)(t + 1) * 128); }
        if (t < NTw) {
            LAS const unsigned char* kb = lds + cur * MLA_KBUF + krd;
            f32x16 s[2]; s[0] = f32x16{}; s[1] = f32x16{};
#pragma unroll
            for (int d0 = 0; d0 < 6; ++d0) {
                const bf16x8 k0 = *(LAS const bf16x8*)(kb + d0 * 32), k1f = *(LAS const bf16x8*)(kb + 32 * MLA_KPITCH + d0 * 32);
                s[0] = __builtin_amdgcn_mfma_f32_32x32x16_bf16(k0, qf[d0], s[0], 0, 0, 0);
                s[1] = __builtin_amdgcn_mfma_f32_32x32x16_bf16(k1f, qf[d0], s[1], 0, 0, 0); }
            float mx = fmaxf(s[0][0], s[1][0]);
#pragma unroll
            for (int r = 1; r < 16; ++r) mx = fmaxf(mx, fmaxf(s[0][r], s[1][r]));
            mx = fmaxf(mx, __shfl_xor(mx, 32));
            const float mnew = fmaxf(mrun, mx), alpha = __builtin_amdgcn_exp2f(mrun - mnew);
            mrun = mnew;
            float ls = 0.f;
#pragma unroll
            for (int r = 0; r < 16; ++r) { s[0][r] = __builtin_amdgcn_exp2f(s[0][r] - mnew); s[1][r] = __builtin_amdgcn_exp2f(s[1][r] - mnew); ls += s[0][r] + s[1][r]; }
            lrun = lrun * alpha + ls;
            o[0] = o[0] * alpha; o[1] = o[1] * alpha;
            LAS const unsigned char* vb = lds + cur * MLA_VBUF + vrd;
#pragma unroll
            for (int g = 0; g < 4; ++g) { const int blk = g >> 1, r0 = 8 * (g & 1);
                u32x4 pw; pw.x = cvtpk(s[blk][r0], s[blk][r0 + 1]); pw.y = cvtpk(s[blk][r0 + 2], s[blk][r0 + 3]); pw.z = cvtpk(s[blk][r0 + 4], s[blk][r0 + 5]); pw.w = cvtpk(s[blk][r0 + 6], s[blk][r0 + 7]);
                const bf16x8 pf = __builtin_bit_cast(bf16x8, pw);
                const bf16x8 v0 = *(LAS const bf16x8*)(vb + g * 32), v1 = *(LAS const bf16x8*)(vb + 32 * MLA_VPITCH + g * 32);
                o[0] = __builtin_amdgcn_mfma_f32_32x32x16_bf16(v0, pf, o[0], 0, 0, 0);
                o[1] = __builtin_amdgcn_mfma_f32_32x32x16_bf16(v1, pf, o[1], 0, 0, 0); }
        }
        if (more) { *(LAS u32x4*)(lds + nxt * MLA_KBUF + klds0) = rk0; if (k1) *(LAS u32x4*)(lds + nxt * MLA_KBUF + klds1) = rk1; *(LAS u32x4*)(lds + nxt * MLA_VBUF + vlds) = rv; }
        __syncthreads();
    }
    const float l = lrun + __shfl_xor(lrun, 32), inv = 1.0f / l;
    const size_t tok = tokbase + q0 + q;
#pragma unroll
    for (int db = 0; db < 2; ++db)
#pragma unroll
        for (int c = 0; c < 4; ++c) { const int d = 32 * db + 8 * c + 4 * hi;
            const u32x2 g = *(const u32x2*)(Gm + tok * 512 + h * 64 + d);
            u32x2 w; w.x = cvtpk(o[db][4 * c] * inv * bflo(g.x), o[db][4 * c + 1] * inv * bfhi(g.x)); w.y = cvtpk(o[db][4 * c + 2] * inv * bflo(g.y), o[db][4 * c + 3] * inv * bfhi(g.y));
            *(u32x2*)(Acat + tok * 1024 + 512 + h * 64 + d) = w; }
}

struct Args { const float* in[12]; float* out; unsigned char* ws; int ph_lo, ph_hi; };

__global__ void __launch_bounds__(NTHREADS, 2) fwd_kernel(Args args) {
    extern __shared__ __attribute__((aligned(16))) unsigned char lds_raw[];
    LAS unsigned char* lds = (LAS unsigned char*)lds_raw;
    const int tid = threadIdx.x, lane = tid & 63, wave = __builtin_amdgcn_readfirstlane(tid >> 6);
    const int G = gridDim.x, bx = blockIdx.x;
    const int vcu = (G % 8 == 0) ? (bx % 8) * (G / 8) + bx / 8 : bx;
    const int gw = vcu * NWAVES + wave, NGW = G * NWAVES;
    unsigned char* ws = args.ws;
    const float* x = args.in[0];
    float* rowsq = (float*)(ws + WS_ROWSQ); float* cosT = (float*)(ws + WS_COS); float* sinT = (float*)(ws + WS_SIN);
    bf16 *Bt1 = (bf16*)(ws + WS_BT1), *Bt2a = (bf16*)(ws + WS_BT2A), *Bt2b = (bf16*)(ws + WS_BT2B), *Bt2c = (bf16*)(ws + WS_BT2C), *Bt4 = (bf16*)(ws + WS_BT4), *Bt5 = (bf16*)(ws + WS_BT5);
    float* Krope = (float*)(ws + WS_KROPE);
    bf16 *H = (bf16*)(ws + WS_H), *Acat = (bf16*)(ws + WS_ACAT), *Qsb = (bf16*)(ws + WS_QSB), *Ksb = (bf16*)(ws + WS_KSB), *VtSb = (bf16*)(ws + WS_VTSB), *Gsb = (bf16*)(ws + WS_GSB), *Merged = (bf16*)(ws + WS_MERGED);
    bf16 *Gmla = (bf16*)(ws + WS_GMLA), *Cq = (bf16*)(ws + WS_CQ), *Ckv = (bf16*)(ws + WS_CKV), *Cqn = (bf16*)(ws + WS_CQN), *Ckvn = (bf16*)(ws + WS_CKVN);
    bf16 *Qm = (bf16*)(ws + WS_QM), *Km = (bf16*)(ws + WS_KM), *VtM = (bf16*)(ws + WS_VTM);
    bf16* Gg = (bf16*)(ws + WS_G);
    const int lo = args.ph_lo, hi = args.ph_hi;
#ifndef PHMASK
#define PHMASK 0xff
#endif
#ifdef DBG_PROBE
#define IN(k) ((k) <= DBG_PROBE && lo <= (k) && (k) < hi)
#else
#define IN(k) (((PHMASK >> (k)) & 1) && lo <= (k) && (k) < hi)
#endif
#define SEAM(k) do { if (IN(k) && IN((k) + 1)) cg::this_grid().sync(); } while (0)

    if (IN(0)) {
        const int gt = vcu * NTHREADS + tid, NGT = G * NTHREADS;
        for (int i = gt; i < M; i += NGT) rowsq[i] = 0.f;
        for (int i = gt; i < SEQ * 16; i += NGT) { const int pos = i >> 4, k = i & 15;
            const float inv_freq = (float)pow(10000.0, -(double)k / 16.0);
            const float ang = (float)pos * inv_freq;
            const double rev = (double)ang * 0.15915494309189535; const float fr = (float)(rev - rint(rev));
            cosT[i] = __builtin_amdgcn_cosf(fr); sinT[i] = __builtin_amdgcn_sinf(fr); }
        LAS float* scr = (LAS float*)(lds + wave * 16384);
        constexpr int I1 = 16 * (N1 / 32), I2A = 6 * 24, I2B = 4 * 16, I2C = 4 * 16, I4A = 8 * 32, I4B = 8 * 32, I5 = 16 * 32;
        constexpr int NITEMS = I1 + I2A + I2B + I2C + I4A + I4B + I5;
        for (int it = gw; it < NITEMS; it += NGW) {
            int r = it;
            if (r < I1) { p0_transpose_item<1>(args.in[2], IN_COLS, Bt1, 1024, 0, N1 / 32, scr, r, lane); continue; } r -= I1;
            if (r < I2A) { p0_transpose_item<2>(args.in[5], 768, Bt2a, 384, 0, 24, scr, r, lane); continue; } r -= I2A;
            if (r < I2B) { p0_transpose_item<3>(args.in[7], 1024, Bt2b, 256, 0, 16, scr, r, lane); continue; } r -= I2B;
            if (r < I2C) { p0_transpose_item<4>(args.in[7], 1024, Bt2c, 256, 0, 16, scr, r, lane); continue; } r -= I2C;
            if (r < I4A) { p0_transpose_item<0>(args.in[8], 1024, Bt4, 1024, 0, 32, scr, r, lane); continue; } r -= I4A;
            if (r < I4B) { p0_transpose_item<0>(args.in[9], 1024, Bt4, 1024, 512, 32, scr, r, lane); continue; } r -= I4B;
            p0_transpose_item<0>(args.in[10], 1024, Bt5, 1024, 0, 32, scr, r, lane);
        }
        const float* gin = args.in[1];
        f32x4 gv[4];
#pragma unroll
        for (int j = 0; j < 4; ++j) gv[j] = *(const f32x4*)(gin + 256 * j + 4 * lane);
        for (int m = gw; m < M; m += NGW) {
            const f32x4* xr = (const f32x4*)(x + (size_t)m * DM) + lane;
            f32x4 v[4]; float s = 0.f;
#pragma unroll
            for (int j = 0; j < 4; ++j) { v[j] = xr[64 * j]; s += (v[j].x * v[j].x + v[j].y * v[j].y) + (v[j].z * v[j].z + v[j].w * v[j].w); }
            const float inv = 1.0f / sqrtf(wave_sum(s) * (1.f / DM) + EPS);
            u32x2* o8 = (u32x2*)(H + (size_t)m * DM) + lane;
#pragma unroll
            for (int j = 0; j < 4; ++j) { u32x2 w; w.x = cvtpk(v[j].x * inv * gv[j].x, v[j].y * inv * gv[j].y); w.y = cvtpk(v[j].z * inv * gv[j].z, v[j].w * inv * gv[j].w); o8[64 * j] = w; }
        }
    }
    SEAM(0);

    if (IN(1)) {
        { pg8::Gemm g{H, Bt1, M, N1A, DM}; pg8::StaticOrder S; S.init(M, N1A, G, bx);
          pg8::Epi1 E{Qsb, Ksb, Gsb, Cq, Ckv, Gmla, Gg, Krope, args.in[3]};
          pg8::gemm_phase<pg8::Epi1, pg8::StaticOrder, true, true>(lds, g, S, E); }
        { pg8::Gemm g{Bt1 + (size_t)N1A * DM, H, 512, M, DM}; pg8::StaticOrder S; S.init(512, M, G, (bx + G - 192 % G) % G);
          pg8::EpiPlain E{VtSb, M};
          pg8::gemm_phase<pg8::EpiPlain, pg8::StaticOrder, true, true>(lds, g, S, E); }
    }
    SEAM(1);

    if (IN(2)) {
        const float* gq = args.in[4]; const float* gkv = args.in[6];
        float gqa[3], gqb[3], gka[2], gkb[2];
#pragma unroll
        for (int i = 0; i < 3; ++i) { gqa[i] = gq[128 * i + 2 * lane]; gqb[i] = gq[128 * i + 2 * lane + 1]; }
#pragma unroll
        for (int i = 0; i < 2; ++i) { gka[i] = gkv[128 * i + 2 * lane]; gkb[i] = gkv[128 * i + 2 * lane + 1]; }
        for (int m = gw; m < M; m += NGW) {
            const int b = m >> 13, s = m & 8191;
            const unsigned* cq = (const unsigned*)(Cq + (size_t)m * 384) + lane; unsigned w[3]; float ss = 0.f;
#pragma unroll
            for (int i = 0; i < 3; ++i) { w[i] = cq[64 * i]; const float a = bflo(w[i]), c = bfhi(w[i]); ss += a * a + c * c; }
            float inv = 1.0f / sqrtf(wave_sum(ss) * (1.f / 384.f) + EPS);
            unsigned* oq = (unsigned*)(Cqn + (size_t)m * 384) + lane;
#pragma unroll
            for (int i = 0; i < 3; ++i) oq[64 * i] = cvtpk(bflo(w[i]) * inv * gqa[i], bfhi(w[i]) * inv * gqb[i]);
            const unsigned* ck = (const unsigned*)(Ckv + (size_t)m * 256) + lane; unsigned wk[2]; ss = 0.f;
#pragma unroll
            for (int i = 0; i < 2; ++i) { wk[i] = ck[64 * i]; const float a = bflo(wk[i]), c = bfhi(wk[i]); ss += a * a + c * c; }
            inv = 1.0f / sqrtf(wave_sum(ss) * (1.f / 256.f) + EPS);
            unsigned* ok = (unsigned*)(Ckvn + (size_t)m * 256) + lane;
#pragma unroll
            for (int i = 0; i < 2; ++i) ok[64 * i] = cvtpk(bflo(wk[i]) * inv * gka[i], bfhi(wk[i]) * inv * gkb[i]);
            const int hh = lane >> 3, jj = lane & 7;
            const f32x2 x1 = *(const f32x2*)(Krope + (size_t)m * 32 + 2 * jj), x2 = *(const f32x2*)(Krope + (size_t)m * 32 + 16 + 2 * jj);
            const f32x2 c2 = *(const f32x2*)(cosT + s * 16 + 2 * jj), s2 = *(const f32x2*)(sinT + s * 16 + 2 * jj);
            const f32x2 o1 = x1 * c2 - x2 * s2, o2 = x1 * s2 + x2 * c2;
            bf16* kd = Km + ((size_t)((b * 8 + hh) * SEQ + s)) * 96 + 64 + 2 * jj;
            *(unsigned*)kd = cvtpk(o1.x, o1.y); *(unsigned*)(kd + 16) = cvtpk(o2.x, o2.y);
        }
    }
    SEAM(2);

    if (IN(3)) {
        { pg8::Gemm g{Cqn, Bt2a, M, 768, 384}; pg8::StaticOrder S; S.init(M, 768, G, bx);
          pg8::Epi2a E{Qm, cosT, sinT, 0.10206207261596577f * L2E};
          pg8::gemm_phase<pg8::Epi2a, pg8::StaticOrder, true, true>(lds, g, S, E); }
        { pg8::Gemm g{Ckvn, Bt2b, M, 512, 256}; pg8::StaticOrder S; S.init(M, 512, G, (bx + G - 192 % G) % G);
          pg8::Epi2b E{Km};
          pg8::gemm_phase<pg8::Epi2b, pg8::StaticOrder, true, true>(lds, g, S, E); }
        { pg8::Gemm g{Bt2c, Ckvn, 512, M, 256}; pg8::StaticOrder S; S.init(512, M, G, (bx + G - 64 % G) % G);
          pg8::EpiPlain E{VtM, M};
          pg8::gemm_phase<pg8::EpiPlain, pg8::StaticOrder, true, true>(lds, g, S, E); }
    }
    SEAM(3);

    if (IN(4)) {
        for (int task = gw; task < 16 * 256; task += NGW) { const int bh = task >> 8, j = task & 255; sb_task(bh >> 3, bh & 7, j, Qsb, Ksb, VtSb, Gsb, Acat, lane); }
        __syncthreads();
        for (int p = vcu; p < 256; p += G) { const int bh = p >> 4, sx = p & 15;
            mla_unit(bh >> 3, bh & 7, 31 - sx, Qm, Km, VtM, Gmla, Acat, lds);
            mla_unit(bh >> 3, bh & 7, sx, Qm, Km, VtM, Gmla, Acat, lds); }
    }
    SEAM(4);

    if (IN(5)) {
        pg8::Gemm g{Acat, Bt4, M, DM, DM}; pg8::StaticOrder S; S.init(M, DM, G, bx);
        pg8::Epi4 E{Gg, Merged};
        pg8::gemm_phase<pg8::Epi4, pg8::StaticOrder, true, true>(lds, g, S, E);
    }
    SEAM(5);

    if (IN(6)) {
        pg8::Gemm g{Merged, Bt5, M, DM, DM}; pg8::StaticOrder S; S.init(M, DM, G, bx);
        pg8::Epi5 E{x, args.out, rowsq};
        pg8::gemm_phase<pg8::Epi5, pg8::StaticOrder, true, true>(lds, g, S, E);
    }
    SEAM(6);

#ifdef DBG_PROBE
    if (lo <= 7 && 7 < hi) {
        const int gt = vcu * NTHREADS + tid, NGT = G * NTHREADS;
        for (size_t i = gt; i < (size_t)M * DM; i += NGT) {
            float v = 0.f;
#if DBG_PROBE == 3
            v += bflo(Qsb[i % ((size_t)M * 512)]) + bflo(Ksb[i % ((size_t)M * 512)]) * 2.f + bflo(VtSb[i % ((size_t)M * 512)]) * 3.f + bflo(Gsb[i % ((size_t)M * 512)]) * 4.f + bflo(Gmla[i % ((size_t)M * 512)]) * 5.f;
            v += bflo(Qm[i % ((size_t)M * 768)]) * 6.f + bflo(Km[i % ((size_t)M * 768)]) * 7.f + bflo(VtM[i % ((size_t)M * 512)]) * 8.f;
#elif DBG_PROBE == 1
            { const unsigned w = ((const unsigned*)Gg)[i]; v = bflo(w) + 3.f * bfhi(w); }
#elif DBG_PROBE == 4
            v += bflo(Acat[i]);
#elif DBG_PROBE == 5
            v += bflo(Merged[i]);
#endif
            args.out[i] = v;
        }
    }
#else
    if (IN(7)) {
        const float* gf = args.in[11];
        f32x4 gv[4];
#pragma unroll
        for (int j = 0; j < 4; ++j) gv[j] = *(const f32x4*)(gf + 256 * j + 4 * lane);
        for (int m = gw; m < M; m += NGW) {
            const float inv = 1.0f / sqrtf(rowsq[m] * (1.f / DM) + EPS);
            f32x4* xr = (f32x4*)(args.out + (size_t)m * DM) + lane;
#pragma unroll
            for (int j = 0; j < 4; ++j) { f32x4 v = xr[64 * j]; v = v * inv * gv[j]; xr[64 * j] = v; }
        }
    }
#endif
#undef IN
#undef SEAM
}

extern "C" void kernel_launch(void* const* d_in, const int* in_sizes, int n_in, void* d_out, int out_size, void* d_ws, size_t ws_size, hipStream_t stream) {
    static int grid = 0;
    if (grid == 0) {
        if (n_in != 12 || in_sizes[0] != M * DM || out_size != M * DM || ws_size < WS_END) { fprintf(stderr, "kernel_launch: unexpected shapes (n_in %d, in0 %d, out %d, ws %zu)\n", n_in, n_in > 0 ? in_sizes[0] : -1, out_size, ws_size); grid = -1; return; }
        int dev = 0, cus = 0, per_cu = 0;
        if (hipGetDevice(&dev) != hipSuccess || hipDeviceGetAttribute(&cus, hipDeviceAttributeMultiprocessorCount, dev) != hipSuccess) { grid = -1; return; }
        if (hipFuncSetAttribute((const void*)fwd_kernel, hipFuncAttributeMaxDynamicSharedMemorySize, LDS_BYTES) != hipSuccess) { fprintf(stderr, "kernel_launch: hipFuncSetAttribute failed\n"); grid = -1; return; }
        if (hipOccupancyMaxActiveBlocksPerMultiprocessor(&per_cu, (const void*)fwd_kernel, NTHREADS, LDS_BYTES) != hipSuccess || per_cu < 1) { fprintf(stderr, "kernel_launch: occupancy query says %d\n", per_cu); per_cu = 1; }
        (void)hipGetLastError();
        grid = cus * 1;
    }
    if (grid < 0) return;
    Args a{};
    for (int i = 0; i < 12; ++i) a.in[i] = (const float*)d_in[i];
    a.out = (float*)d_out; a.ws = (unsigned char*)d_ws;
#if MK_N_LAUNCHES == 1
    a.ph_lo = 0; a.ph_hi = N_PHASES;
    void* kargs[] = {&a};
    hipError_t e = hipLaunchCooperativeKernel((const void*)fwd_kernel, dim3(grid), dim3(NTHREADS), kargs, LDS_BYTES, stream);
    if (e != hipSuccess) fprintf(stderr, "kernel_launch: cooperative launch failed: %s (grid %d)\n", hipGetErrorString(e), grid);
#else
    for (int p = 0; p < N_PHASES; ++p) { a.ph_lo = p; a.ph_hi = p + 1;
        hipLaunchKernelGGL(fwd_kernel, dim3(grid), dim3(NTHREADS), LDS_BYTES, stream, a);
        const hipError_t le = hipPeekAtLastError();
        if (le != hipSuccess) { fprintf(stderr, "kernel_launch: launch %d failed: %s\n", p, hipGetErrorName(le)); break; } }
#endif
}
```

```cpp
#include <hip/hip_runtime.h>
#include <hip/hip_cooperative_groups.h>
#include <cstdio>
#include <cstdint>
#include <cmath>
namespace cg = cooperative_groups;
namespace pg8 {
#define PG8_LAS __attribute__((address_space(3)))
typedef unsigned short bf16_t;
typedef short bf16x8 __attribute__((ext_vector_type(8)));
typedef float f32x4 __attribute__((ext_vector_type(4)));
typedef unsigned u32x4 __attribute__((ext_vector_type(4)));
constexpr int BM = 256, BK = 64, HALF = 128, HTB = HALF * BK * 2  , STAGE_BYTES = 8 * HTB, NXCD = 8, WGM = 8;

__host__ __device__ __forceinline__ int lds_byte(int r, int c) { const int st = (r >> 4) * 2 + (c >> 5), rr = r & 15, cc = c & 31, ob = rr * 64 + cc * 2; return st * 1024 + (ob ^ (((ob >> 9) & 1) << 5)); }
__host__ __device__ __forceinline__ void stage_rc(int b, int& R, int& C) { const int st = b / 1024, sb = b % 1024, swz = sb ^ (((sb >> 9) & 1) << 5); R = (st >> 1) * 16 + swz / 64; C = (st & 1) * 32 + (swz % 64) / 2; }
__host__ __device__ __forceinline__ int perm32(int rho) { const int n = rho >> 4, i = rho & 15; return 8 * (i >> 2) + 4 * n + (i & 3); }

struct Unit { int pm, pn; };
struct Gemm { const bf16_t* A; const bf16_t* Bt; int M, N, K; };

struct StaticOrder {
    int nM, nN, nwg, G, c;
    __host__ __device__ void init(int M, int N, int G_, int c_) { nM = M / BM; nN = N / BM; nwg = nM * nN; G = G_; c = c_; }
    __host__ __device__ bool next(int i, Unit& u) const {
        const long L = (long)i * G + c; if (L >= nwg) return false;
        int wgid = (int)L; { const int q = nwg / NXCD, r = nwg % NXCD, xcd = wgid % NXCD, off = wgid / NXCD; wgid = (xcd < r ? xcd * (q + 1) : r * (q + 1) + (xcd - r) * q) + off; }
        const int nig = WGM * nN, gid = wgid / nig, fm = gid * WGM, gsz = (nM - fm) < WGM ? (nM - fm) : WGM;
        u.pm = fm + ((wgid % nig) % gsz); u.pn = (wgid % nig) / gsz; return true;
    }
    __device__ __forceinline__ void a_ready(const Unit&) const {}
    __device__ __forceinline__ void done(const Unit&) const {}
};

typedef float f32x2_cv __attribute__((ext_vector_type(2))); typedef __bf16 bf16x2_cv __attribute__((ext_vector_type(2)));
__device__ __forceinline__ unsigned cvt_pk_bf16(float lo, float hi) { f32x2_cv v = {lo, hi}; bf16x2_cv b = __builtin_convertvector(v, bf16x2_cv); return __builtin_bit_cast(unsigned, b); }
typedef unsigned u32x2 __attribute__((ext_vector_type(2)));
__device__ __forceinline__ u32x4 pack8(f32x4 a, f32x4 b) { u32x4 w; w.x = cvt_pk_bf16(a[0], a[1]); w.y = cvt_pk_bf16(a[2], a[3]); w.z = cvt_pk_bf16(b[0], b[1]); w.w = cvt_pk_bf16(b[2], b[3]); return w; }
__device__ __forceinline__ u32x2 pack4(f32x4 a) { u32x2 w; w.x = cvt_pk_bf16(a[0], a[1]); w.y = cvt_pk_bf16(a[2], a[3]); return w; }
__device__ __forceinline__ void unpack8(u32x4 w, f32x4& a, f32x4& b) {
    a[0] = __uint_as_float(w.x << 16); a[1] = __uint_as_float(w.x & 0xffff0000u); a[2] = __uint_as_float(w.y << 16); a[3] = __uint_as_float(w.y & 0xffff0000u);
    b[0] = __uint_as_float(w.z << 16); b[1] = __uint_as_float(w.z & 0xffff0000u); b[2] = __uint_as_float(w.w << 16); b[3] = __uint_as_float(w.w & 0xffff0000u); }
__device__ __forceinline__ float sigmoid_fast(float v) { return __builtin_amdgcn_rcpf(1.0f + __builtin_amdgcn_exp2f(-1.4426950408889634f * v)); }

struct Epi1 {
    static constexpr bool PERM = true, AFTER_DRAIN = false, HAS_MID = false;
    bf16_t *Qsb, *Ksb, *Gsb, *Cq, *Ckv, *Gmla, *G; float* Krope; const float* bgate;
    template <int MODE> __device__ __forceinline__ void tile(const f32x4 (&acc)[2][2][4][2], bf16_t* base, int ld, int colt, float sc, int row0, int wc, int fq) const {
#pragma unroll
        for (int bj = 0; bj < 2; ++bj) { const int col = colt + bj * HALF + wc * 32 + 8 * fq;
            f32x4 b0 = (f32x4){0.f, 0.f, 0.f, 0.f}, b1 = b0;
#ifndef DBG_NOBIAS
            if (MODE == 2) { b0 = *(const f32x4*)(bgate + col); b1 = *(const f32x4*)(bgate + col + 4); }
#endif
#pragma unroll
            for (int ai = 0; ai < 2; ++ai)
#pragma unroll
                for (int m = 0; m < 4; ++m) { bf16_t* p = base + (size_t)(row0 + ai * HALF + m * 16) * ld + col;
                    f32x4 v0 = acc[ai][bj][m][0], v1 = acc[ai][bj][m][1];
                    if (MODE == 0) { v0 = v0 * sc; v1 = v1 * sc; }
                    else { v0 = v0 + b0; v1 = v1 + b1;
#pragma unroll
                        for (int e = 0; e < 4; ++e) { const float s0 = sigmoid_fast(v0[e]), s1 = sigmoid_fast(v1[e]); v0[e] = (MODE == 1) ? v0[e] * s0 : s0; v1[e] = (MODE == 1) ? v1[e] * s1 : s1; } }
                    *(u32x4*)p = pack8(v0, v1); } }
    }
    __device__ __forceinline__ void operator()(const f32x4 (&acc)[2][2][4][2], const Unit& u, int wr, int wc, int fr, int fq) const {
        asm volatile("" : "+v"(fr), "+v"(fq));
#ifdef DBG_ROT
        const int row0 = u.pm * BM + wr * 64 + fr, pn = (u.pn + 11) % 19;
#else
        const int row0 = u.pm * BM + wr * 64 + fr, pn = u.pn;
#endif
        if (pn < 2) tile<0>(acc, Qsb, 512, pn * 256, 0.125f, row0, wc, fq);
        else if (pn < 4) tile<0>(acc, Ksb, 512, (pn - 2) * 256, 1.f, row0, wc, fq);
        else if (pn < 6) tile<1>(acc, Gsb, 512, (pn - 4) * 256, 1.f, row0, wc, fq);
        else if (pn == 6) tile<0>(acc, Cq, 384, 0, 1.f, row0, wc, fq);
        else if (pn == 7) {
#pragma unroll
            for (int ai = 0; ai < 2; ++ai)
#pragma unroll
                for (int m = 0; m < 4; ++m) { const size_t row = (size_t)(row0 + ai * HALF + m * 16);
                    *(u32x4*)(Cq + row * 384 + 256 + wc * 32 + 8 * fq) = pack8(acc[ai][0][m][0], acc[ai][0][m][1]);
                    if (wc == 0) { float* kp = Krope + row * 32 + 8 * fq; *(f32x4*)kp = acc[ai][1][m][0]; *(f32x4*)(kp + 4) = acc[ai][1][m][1]; } }
        }
        else if (pn == 8) tile<0>(acc, Ckv, 256, 0, 1.f, row0, wc, fq);
        else if (pn < 11) tile<1>(acc, Gmla, 512, (pn - 9) * 256, 1.f, row0, wc, fq);
        else tile<2>(acc, G, 2048, (pn - 11) * 256, 1.f, row0, wc, fq);
    }
};
struct EpiPlain {
    static constexpr bool PERM = true, AFTER_DRAIN = false, HAS_MID = false;
    bf16_t* O; int ldc;
    __device__ __forceinline__ void operator()(const f32x4 (&acc)[2][2][4][2], const Unit& u, int wr, int wc, int fr, int fq) const {
        asm volatile("" : "+v"(fr), "+v"(fq));
        const int row0 = u.pm * BM + wr * 64 + fr, col0 = u.pn * BM + wc * 32 + 8 * fq;
#pragma unroll
        for (int ai = 0; ai < 2; ++ai)
#pragma unroll
            for (int m = 0; m < 4; ++m)
#pragma unroll
                for (int bj = 0; bj < 2; ++bj) *(u32x4*)(O + (size_t)(row0 + ai * HALF + m * 16) * ldc + col0 + bj * HALF) = pack8(acc[ai][bj][m][0], acc[ai][bj][m][1]);
    }
};
struct Epi2a {
    static constexpr bool PERM = true, AFTER_DRAIN = false, HAS_MID = false;
    bf16_t* Qm; const float* cosT; const float* sinT; float qs;
    __device__ __forceinline__ void operator()(const f32x4 (&acc)[2][2][4][2], const Unit& u, int wr, int wc, int fr, int fq) const {
        asm volatile("" : "+v"(fr), "+v"(fq));
        const int row0 = u.pm * BM + wr * 64 + fr;
        if (u.pn < 2) {
#pragma unroll
            for (int ai = 0; ai < 2; ++ai)
#pragma unroll
                for (int m = 0; m < 4; ++m) { const int row = row0 + ai * HALF + m * 16, b = row >> 13, s = row & 8191;
#pragma unroll
                    for (int bj = 0; bj < 2; ++bj) { const int col = u.pn * 256 + bj * HALF + wc * 32 + 8 * fq, h = col >> 6, d = col & 63;
                        *(u32x4*)(Qm + ((size_t)((b * 8 + h) * 8192 + s)) * 96 + d) = pack8(acc[ai][bj][m][0] * qs, acc[ai][bj][m][1] * qs); } }
        } else {
#pragma unroll
            for (int ai = 0; ai < 2; ++ai)
#pragma unroll
                for (int m = 0; m < 4; ++m) { const int row = row0 + ai * HALF + m * 16, b = row >> 13, s = row & 8191;
                    const f32x4 c4 = *(const f32x4*)(cosT + s * 16 + 4 * fq), s4 = *(const f32x4*)(sinT + s * 16 + 4 * fq);
#pragma unroll
                    for (int bj = 0; bj < 2; ++bj) { const int h = bj * 4 + wc; const f32x4 x1 = acc[ai][bj][m][0], x2 = acc[ai][bj][m][1];
                        const f32x4 o1 = (x1 * c4 - x2 * s4) * qs, o2 = (x1 * s4 + x2 * c4) * qs;
                        bf16_t* p = Qm + ((size_t)((b * 8 + h) * 8192 + s)) * 96 + 64 + 4 * fq;
                        *(u32x2*)p = pack4(o1); *(u32x2*)(p + 16) = pack4(o2); }
                    asm volatile("" ::: "memory"); }
        }
    }
};
struct Epi2b {
    static constexpr bool PERM = true, AFTER_DRAIN = false, HAS_MID = false;
    bf16_t* Km;
    __device__ __forceinline__ void operator()(const f32x4 (&acc)[2][2][4][2], const Unit& u, int wr, int wc, int fr, int fq) const {
        asm volatile("" : "+v"(fr), "+v"(fq));
        const int row0 = u.pm * BM + wr * 64 + fr;
#pragma unroll
        for (int ai = 0; ai < 2; ++ai)
#pragma unroll
            for (int m = 0; m < 4; ++m) { const int row = row0 + ai * HALF + m * 16, b = row >> 13, s = row & 8191;
#pragma unroll
                for (int bj = 0; bj < 2; ++bj) { const int col = u.pn * 256 + bj * HALF + wc * 32 + 8 * fq, h = col >> 6, d = col & 63;
                    *(u32x4*)(Km + ((size_t)((b * 8 + h) * 8192 + s)) * 96 + d) = pack8(acc[ai][bj][m][0], acc[ai][bj][m][1]); } }
    }
};
struct Epi4 {
    static constexpr bool PERM = true, AFTER_DRAIN = false, HAS_MID = true;
    const bf16_t* G; bf16_t* Mg;
    __device__ __forceinline__ void mid(f32x4 (&acc)[2][2][4][2], const Unit& u, int wr, int wc, int fr, int fq) const {
        asm volatile("" : "+v"(fr), "+v"(fq));
        const int row0 = u.pm * BM + wr * 64 + fr, col0 = u.pn * BM + wc * 32 + 8 * fq;
#pragma unroll
        for (int ai = 0; ai < 2; ++ai)
#pragma unroll
            for (int m = 0; m < 4; ++m)
#pragma unroll
                for (int bj = 0; bj < 2; ++bj) { const bf16_t* gp = G + (size_t)(row0 + ai * HALF + m * 16) * 2048 + col0 + bj * HALF;
                    f32x4 a0, a1, m0, m1; unpack8(*(const u32x4*)gp, a0, a1); unpack8(*(const u32x4*)(gp + 1024), m0, m1);
#pragma unroll
                    for (int e = 0; e < 4; ++e) { acc[ai][bj][m][0][e] *= a0[e] * __builtin_amdgcn_rcpf(fmaxf(m0[e], 1e-20f)); acc[ai][bj][m][1][e] *= a1[e] * __builtin_amdgcn_rcpf(fmaxf(m1[e], 1e-20f)); } }
    }
    __device__ __forceinline__ void operator()(const f32x4 (&acc)[2][2][4][2], const Unit& u, int wr, int wc, int fr, int fq) const {
        asm volatile("" : "+v"(fr), "+v"(fq));
        const int row0 = u.pm * BM + wr * 64 + fr, col0 = u.pn * BM + wc * 32 + 8 * fq;
#pragma unroll
        for (int ai = 0; ai < 2; ++ai)
#pragma unroll
            for (int m = 0; m < 4; ++m)
#pragma unroll
                for (int bj = 0; bj < 2; ++bj) { const size_t row = (size_t)(row0 + ai * HALF + m * 16); const int col = col0 + bj * HALF;
                    f32x4 m0, m1; unpack8(*(const u32x4*)(G + row * 2048 + 1024 + col), m0, m1);
                    f32x4 v0 = acc[ai][bj][m][0], v1 = acc[ai][bj][m][1];
#pragma unroll
                    for (int e = 0; e < 4; ++e) { v0[e] *= fmaxf(m0[e], 1e-20f); v1[e] *= fmaxf(m1[e], 1e-20f); }
                    *(u32x4*)(Mg + row * 1024 + col) = pack8(v0, v1); }
    }
};
struct Epi5 {
    static constexpr bool PERM = true, AFTER_DRAIN = false, HAS_MID = false;
    const float* X; float* Out; float* rowsq;
    __device__ __forceinline__ void operator()(const f32x4 (&acc)[2][2][4][2], const Unit& u, int wr, int wc, int fr, int fq) const {
        asm volatile("" : "+v"(fr), "+v"(fq));
        const int row0 = u.pm * BM + wr * 64 + fr, col0 = u.pn * BM + wc * 32 + 8 * fq;
#pragma unroll
        for (int ai = 0; ai < 2; ++ai)
#pragma unroll
            for (int m = 0; m < 4; ++m) { const size_t row = (size_t)(row0 + ai * HALF + m * 16); float ss = 0.f;
#pragma unroll
                for (int bj = 0; bj < 2; ++bj) { const size_t off = row * 1024 + col0 + bj * HALF;
                    const f32x4 v0 = *(const f32x4*)(X + off) + acc[ai][bj][m][0], v1 = *(const f32x4*)(X + off + 4) + acc[ai][bj][m][1];
                    *(f32x4*)(Out + off) = v0; *(f32x4*)(Out + off + 4) = v1;
                    ss += (v0[0] * v0[0] + v0[1] * v0[1]) + (v0[2] * v0[2] + v0[3] * v0[3]) + (v1[0] * v1[0] + v1[1] * v1[1]) + (v1[2] * v1[2] + v1[3] * v1[3]); }
                ss += __shfl_xor(ss, 16); ss += __shfl_xor(ss, 32);
#ifdef REP_P6
                ss *= (1.0f / REP_P6);
#endif
                if (fq == 0) atomicAdd(rowsq + row, ss); }
    }
};

template <class Epi, class Sched, bool ALIGN_EPI = false, bool SP2 = false>
__device__ __forceinline__ void gemm_phase(PG8_LAS unsigned char* lds, const Gemm g, const Sched& S, const Epi& E) {
    const int tid = threadIdx.x, wid = __builtin_amdgcn_readfirstlane(tid >> 6), lane = tid & 63, wr = wid >> 2, wc = wid & 3, fr = lane & 15, fq = lane >> 4;
    int K = g.K; asm volatile("" : "+s"(K));
    const int nt = K / BK;
    unsigned voffA[2], voffB[2];
#pragma unroll
    for (int i = 0; i < 2; ++i) { int R, C; stage_rc(tid * 16 + i * 8192, R, C); const int Rb = Epi::PERM ? ((R & ~31) + perm32(R & 31)) : R;
        voffA[i] = (unsigned)(R * K + C) * 2u; voffB[i] = (unsigned)(Rb * K + C) * 2u; }
    const size_t kstep = (size_t)(BK * 2);
    const size_t hstep = (size_t)HALF * K * 2;
    const size_t tstep = 2 * hstep;
    const unsigned ldsw = (unsigned)wid * 1024u;
    const int aoff = lds_byte(wr * 64 + fr, fq * 8), boff = lds_byte(wc * 32 + fr, fq * 8);
#define PG8_SA(b, h) (((b) * 2 + (h)) * HTB)
#define PG8_SB(b, h) ((4 + (b) * 2 + (h)) * HTB)
#define PG8_STAGE(bufoff, gbase, voff) do { _Pragma("unroll") for (int _i = 0; _i < 2; ++_i) \
        __builtin_amdgcn_global_load_lds((const unsigned*)((const char*)(gbase) + (voff)[_i]), (PG8_LAS unsigned*)(lds + (bufoff) + ldsw + _i * 8192), 16, 0, 0); } while (0)
#define PG8_LDA(dst, b, h) do { _Pragma("unroll") for (int m = 0; m < 4; ++m) _Pragma("unroll") for (int k = 0; k < 2; ++k) dst[m][k] = *(const PG8_LAS bf16x8*)(lds + PG8_SA(b, h) + aoff + m * 2048 + k * 1024); } while (0)
#define PG8_LDB(dst, b, h) do { _Pragma("unroll") for (int n = 0; n < 2; ++n) _Pragma("unroll") for (int k = 0; k < 2; ++k) dst[n][k] = *(const PG8_LAS bf16x8*)(lds + PG8_SB(b, h) + boff + n * 2048 + k * 1024); } while (0)
#define PG8_MMA(ai, bj, At, Bt) do { __builtin_amdgcn_s_setprio(1); _Pragma("unroll") for (int m = 0; m < 4; ++m) _Pragma("unroll") for (int n = 0; n < 2; ++n) _Pragma("unroll") for (int k = 0; k < 2; ++k) \
        acc[ai][bj][m][n] = __builtin_amdgcn_mfma_f32_16x16x32_bf16(Bt[n][k], At[m][k], acc[ai][bj][m][n], 0, 0, 0); __builtin_amdgcn_s_setprio(0); } while (0)
#define PG8_WAIT_V(n) asm volatile("s_waitcnt vmcnt(" #n ")" ::: "memory")
#define PG8_WAIT_L(n) asm volatile("s_waitcnt lgkmcnt(" #n ")" ::: "memory")
#define PG8_BAR __builtin_amdgcn_s_barrier()
#define PG8_SCHED __builtin_amdgcn_sched_barrier(0)
    Unit cur, nxt; int ui = 0;
    if (!S.next(0, cur)) return;
    f32x4 acc[2][2][4][2];
#pragma unroll
    for (int a = 0; a < 2; ++a)
#pragma unroll
        for (int b = 0; b < 2; ++b)
#pragma unroll
            for (int m = 0; m < 4; ++m)
#pragma unroll
                for (int n = 0; n < 2; ++n) acc[a][b][m][n] = (f32x4){0.f, 0.f, 0.f, 0.f};
    bf16x8 At[4][2], B0[2][2], B1[2][2];
    const char* cA = (const char*)g.A + (size_t)cur.pm * tstep; const char* cB = (const char*)g.Bt + (size_t)cur.pn * tstep;
    S.a_ready(cur);
    if constexpr (SP2) {
        PG8_STAGE(PG8_SB(0, 0), cB, voffB); PG8_STAGE(PG8_SB(0, 1), cB + hstep, voffB); PG8_STAGE(PG8_SA(0, 0), cA, voffA); PG8_STAGE(PG8_SA(0, 1), cA + hstep, voffA);
        if (wr == 1) PG8_BAR;
        PG8_WAIT_V(2); PG8_BAR;
        PG8_STAGE(PG8_SB(1, 0), cB + kstep, voffB); PG8_STAGE(PG8_SA(1, 0), cA + kstep, voffA); PG8_STAGE(PG8_SB(1, 1), cB + hstep + kstep, voffB);
        PG8_WAIT_V(6); PG8_BAR;
    } else {
        PG8_STAGE(PG8_SB(0, 0), cB, voffB); PG8_STAGE(PG8_SA(0, 0), cA, voffA); PG8_STAGE(PG8_SB(0, 1), cB + hstep, voffB); PG8_STAGE(PG8_SA(0, 1), cA + hstep, voffA);
        if (wr == 1) PG8_BAR;
        PG8_WAIT_V(4); PG8_BAR;
        PG8_STAGE(PG8_SB(1, 0), cB + kstep, voffB); PG8_STAGE(PG8_SA(1, 0), cA + kstep, voffA); PG8_STAGE(PG8_SB(1, 1), cB + hstep + kstep, voffB);
        PG8_WAIT_V(6); PG8_BAR;
    }
    for (;;) {
        const bool has_next = S.next(ui + 1, nxt);
        const char* nA = has_next ? (const char*)g.A + (size_t)nxt.pm * tstep : cA; const char* nB = has_next ? (const char*)g.Bt + (size_t)nxt.pn * tstep : cB;
        for (int t = 0; t < nt; t += 2) {
            if constexpr (Epi::HAS_MID) { if (t == nt / 2) E.mid(acc, cur, wr, wc, fr, fq); }
            const bool last = (t == nt - 2);
            const char* a1 = cA + (size_t)(t + 1) * kstep;
            const char* a2 = last ? nA : cA + (size_t)(t + 2) * kstep; const char* b2 = last ? nB : cB + (size_t)(t + 2) * kstep;
            const char* a3 = a2 + kstep; const char* b3 = b2 + kstep;
            if (last && has_next) S.a_ready(nxt);
            if constexpr (SP2) {
            PG8_LDB(B0, 0, 0); PG8_LDB(B1, 0, 1); PG8_SCHED; PG8_LDA(At, 0, 0); PG8_STAGE(PG8_SA(1, 1), a1 + hstep, voffA);
            PG8_WAIT_V(8); PG8_WAIT_L(0); PG8_BAR; PG8_MMA(0, 0, At, B0); PG8_MMA(0, 1, At, B1); PG8_BAR; PG8_SCHED;
            PG8_LDA(At, 0, 1); PG8_STAGE(PG8_SB(0, 0), b2, voffB); PG8_STAGE(PG8_SB(0, 1), b2 + hstep, voffB); PG8_STAGE(PG8_SA(0, 0), a2, voffA);
            PG8_WAIT_V(8); PG8_WAIT_L(0); PG8_BAR; PG8_MMA(1, 0, At, B0); PG8_MMA(1, 1, At, B1); PG8_BAR; PG8_SCHED;
            PG8_LDB(B0, 1, 0); PG8_LDB(B1, 1, 1); PG8_SCHED; PG8_LDA(At, 1, 0); PG8_STAGE(PG8_SA(0, 1), a2 + hstep, voffA);
            PG8_WAIT_V(8); PG8_WAIT_L(0); PG8_BAR; PG8_MMA(0, 0, At, B0); PG8_MMA(0, 1, At, B1); PG8_BAR; PG8_SCHED;
            PG8_LDA(At, 1, 1); PG8_STAGE(PG8_SB(1, 0), b3, voffB); PG8_STAGE(PG8_SB(1, 1), b3 + hstep, voffB); PG8_STAGE(PG8_SA(1, 0), a3, voffA);
            PG8_WAIT_V(8); PG8_WAIT_L(0); PG8_BAR; PG8_MMA(1, 0, At, B0); PG8_MMA(1, 1, At, B1); PG8_BAR; PG8_SCHED;
            } else {
            PG8_LDB(B0, 0, 0); PG8_SCHED; PG8_LDA(At, 0, 0); PG8_STAGE(PG8_SA(1, 1), a1 + hstep, voffA);
            PG8_WAIT_L(8); PG8_BAR; PG8_WAIT_L(0); PG8_MMA(0, 0, At, B0); PG8_BAR; PG8_SCHED;
            PG8_LDB(B1, 0, 1); PG8_STAGE(PG8_SB(0, 0), b2, voffB);
            PG8_BAR; PG8_WAIT_L(0); PG8_MMA(0, 1, At, B1); PG8_BAR;
            PG8_LDA(At, 0, 1); PG8_STAGE(PG8_SA(0, 0), a2, voffA);
            PG8_BAR; PG8_WAIT_L(0); PG8_MMA(1, 0, At, B0); PG8_BAR; PG8_SCHED;
            PG8_STAGE(PG8_SB(0, 1), b2 + hstep, voffB);
            PG8_WAIT_V(6); PG8_BAR; PG8_MMA(1, 1, At, B1); PG8_BAR;
            PG8_LDB(B0, 1, 0); PG8_SCHED; PG8_LDA(At, 1, 0); PG8_STAGE(PG8_SA(0, 1), a2 + hstep, voffA);
            PG8_WAIT_L(8); PG8_BAR; PG8_WAIT_L(0); PG8_MMA(0, 0, At, B0); PG8_BAR; PG8_SCHED;
            PG8_LDB(B1, 1, 1); PG8_STAGE(PG8_SB(1, 0), b3, voffB);
            PG8_BAR; PG8_WAIT_L(0); PG8_MMA(0, 1, At, B1); PG8_BAR;
            PG8_LDA(At, 1, 1); PG8_STAGE(PG8_SA(1, 0), a3, voffA);
            PG8_BAR; PG8_WAIT_L(0); PG8_MMA(1, 0, At, B0); PG8_BAR; PG8_SCHED;
            PG8_STAGE(PG8_SB(1, 1), b3 + hstep, voffB);
            PG8_WAIT_V(6); PG8_BAR; PG8_MMA(1, 1, At, B1); PG8_BAR;
            }
        }
        if constexpr (ALIGN_EPI) { if (wr == 0) PG8_BAR; }
        if constexpr (!Epi::AFTER_DRAIN) { E(acc, cur, wr, wc, fr, fq); S.done(cur); }
        if (!has_next) break;
#pragma unroll
        for (int a = 0; a < 2; ++a)
#pragma unroll
            for (int b = 0; b < 2; ++b)
#pragma unroll
                for (int m = 0; m < 4; ++m)
#pragma unroll
                    for (int n = 0; n < 2; ++n) acc[a][b][m][n] = (f32x4){0.f, 0.f, 0.f, 0.f};
        cur = nxt; cA = nA; cB = nB; ++ui;
        if constexpr (ALIGN_EPI) { if (wr == 1) PG8_BAR; }
    }
    PG8_WAIT_V(0);
    if constexpr (!ALIGN_EPI) { if (wr == 0) PG8_BAR; }
    PG8_BAR;
    if constexpr (Epi::AFTER_DRAIN) { E.fused(acc, cur, wr, wc, fr, fq, lds, wid, lane); S.done(cur); }
#undef PG8_SA
#undef PG8_SB
#undef PG8_STAGE
#undef PG8_LDA
#undef PG8_LDB
#undef PG8_MMA
#undef PG8_WAIT_V
#undef PG8_WAIT_L
#undef PG8_BAR
#undef PG8_SCHED
}
}

#define LAS __attribute__((address_space(3)))
typedef unsigned short bf16;
typedef short bf16x8 __attribute__((ext_vector_type(8)));
typedef float f32x4 __attribute__((ext_vector_type(4)));
typedef float f32x2 __attribute__((ext_vector_type(2)));
typedef float f32x16 __attribute__((ext_vector_type(16)));
typedef unsigned u32x4 __attribute__((ext_vector_type(4)));
typedef unsigned u32x2 __attribute__((ext_vector_type(2)));

constexpr int NWAVES = 8, NTHREADS = 512;
constexpr int BATCH = 2, SEQ = 8192, DM = 1024, M = BATCH * SEQ;
constexpr int IN_COLS = 5280;
constexpr float EPS = 1e-6f;
constexpr float L2E = 1.4426950408889634f;
constexpr int LDS_BYTES = 147456;
#ifndef MK_N_LAUNCHES
#define MK_N_LAUNCHES 1
#endif
constexpr int N_PHASES = 8;

constexpr size_t MiB = 1u << 20;
constexpr size_t KiB = 1u << 10;
constexpr size_t WS_BAR = 512 * KiB, BAR_ZERO_BYTES = 16 * KiB;
constexpr size_t WS_ROWSQ = 0, WS_BT4 = 1 * MiB, WS_BT5 = 3 * MiB, WS_COS = 5 * MiB, WS_SIN = 5 * MiB + 512 * KiB;
constexpr size_t WS_BT2A = 6 * MiB, WS_BT2B = 6 * MiB + 768 * KiB, WS_BT2C = 7 * MiB, WS_KROPE = 7 * MiB + 256 * KiB;
constexpr size_t WS_G = 10 * MiB;
constexpr size_t WS_QSB = 74 * MiB, WS_KSB = 90 * MiB, WS_VTSB = 106 * MiB, WS_GSB = 122 * MiB, WS_GMLA = 138 * MiB;
constexpr size_t WS_MERGED = 74 * MiB;
constexpr size_t WS_KM = 154 * MiB, WS_QM = 178 * MiB, WS_VTM = 202 * MiB, WS_ACAT = 218 * MiB;
constexpr size_t WS_BT1 = 154 * MiB;
constexpr size_t WS_CQ = 178 * MiB, WS_CKV = 190 * MiB;
constexpr size_t WS_H = 218 * MiB;
constexpr size_t WS_CQN = 218 * MiB, WS_CKVN = 230 * MiB;
constexpr size_t WS_END = 256 * MiB;
constexpr int N1A = 4864, N1 = 5376;

__device__ __forceinline__ float wave_sum(float v) {
#pragma unroll
    for (int o = 1; o < 64; o <<= 1) v += __shfl_xor(v, o);
    return v;
}
__device__ __forceinline__ unsigned cvtpk(float lo, float hi) { return pg8::cvt_pk_bf16(lo, hi); }
__device__ __forceinline__ float bflo(unsigned w) { return __uint_as_float(w << 16); }
__device__ __forceinline__ float bfhi(unsigned w) { return __uint_as_float(w & 0xffff0000u); }

__device__ __forceinline__ int map_w_in(int n) {
    if (n >= N1A) return 1024 + (n - N1A);
#ifdef DBG_ROT
    const int t = ((n >> 8) + 11) % 19, w = n & 255; n = t * 256 + w;
#else
    const int t = n >> 8, w = n & 255;
#endif
    if (t < 4) return n;
    if (t < 6) return 1536 + (n - 1024);
    if (t == 6) return 2048 + w;
    if (t == 7) return w < 128 ? 2304 + w : (w < 160 ? 2688 + (w - 128) : -1);
    if (t == 8) return 2432 + w;
    if (t < 11) return 2720 + (n - 9 * 256);
    return 3232 + (n - 11 * 256);
}
__device__ __forceinline__ int map_q_up(int n) {
    if (n < 512) return (n >> 6) * 96 + (n & 63);
    const int r = n - 512, h = r >> 5, p = r & 31, fq = p >> 3, half = (p >> 2) & 1, i = p & 3;
    return h * 96 + 64 + half * 16 + 4 * fq + i;
}
template <int MAP> __device__ __forceinline__ void p0_transpose_item(const float* W, int Nsrc, bf16* WT, int kpitch, int koff, int nblk, LAS float* scr, int item, int lane) {
    const int kb = item / nblk, nb = item % nblk, k0 = 64 * kb, n0 = 32 * nb;
    const int n = n0 + (lane & 31);
    int src;
    if (MAP == 0) src = n; else if (MAP == 1) src = map_w_in(n); else if (MAP == 2) src = map_q_up(n); else if (MAP == 3) src = (n >> 6) * 128 + (n & 63); else src = (n >> 6) * 128 + 64 + (n & 63);
#pragma unroll 8
    for (int i = 0; i < 32; ++i) { const int kk = 2 * i + (lane >> 5); scr[kk * 33 + (lane & 31)] = src >= 0 ? W[(size_t)(k0 + kk) * Nsrc + src] : 0.f; }
    asm volatile("s_waitcnt lgkmcnt(0)" ::: "memory");
    const int c = lane & 7;
#pragma unroll
    for (int j = 0; j < 4; ++j) { const int nn = (lane >> 3) + 8 * j; const LAS float* s = scr + (8 * c) * 33 + nn;
        u32x4 o; o.x = cvtpk(s[0 * 33], s[1 * 33]); o.y = cvtpk(s[2 * 33], s[3 * 33]); o.z = cvtpk(s[4 * 33], s[5 * 33]); o.w = cvtpk(s[6 * 33], s[7 * 33]);
        *(u32x4*)(WT + (size_t)(n0 + nn) * kpitch + koff + k0 + 8 * c) = o; }
    asm volatile("s_waitcnt lgkmcnt(0)" ::: "memory");
}

__device__ __forceinline__ int swap23(int m) { return (m & ~12) | ((m & 4) << 1) | ((m & 8) >> 1); }
__device__ __forceinline__ void sb_task(int b, int h, int j, const bf16* __restrict__ Qsb, const bf16* __restrict__ Ksb, const bf16* __restrict__ Vt, const bf16* __restrict__ Gsb, bf16* __restrict__ Acat, int lane) {
    const int q = lane & 31, hi = lane >> 5, q0 = 32 * j, qpos = q0 + q;
    const size_t tokbase = (size_t)b * SEQ;
    bf16x8 qf[4];
    { const bf16* qp = Qsb + (tokbase + q0 + q) * 512 + h * 64 + hi * 8;
#pragma unroll
      for (int d0 = 0; d0 < 4; ++d0) qf[d0] = *(const bf16x8*)(qp + d0 * 16); }
    f32x16 o[2]; o[0] = f32x16{}; o[1] = f32x16{};
    float carry = 0.f;
    const int krow = swap23(q);
    for (int kt = j >> 1; kt >= 0; --kt) {
        const int key0 = kt * 64;
        const bool diag = (kt == (j >> 1));
        const bf16* kp = Ksb + (tokbase + key0 + krow) * 512 + h * 64 + hi * 8;
        bf16x8 kf[2][4];
#pragma unroll
        for (int blk = 0; blk < 2; ++blk)
#pragma unroll
            for (int d0 = 0; d0 < 4; ++d0) kf[blk][d0] = *(const bf16x8*)(kp + (size_t)blk * 32 * 512 + d0 * 16);
        const bf16* vp = Vt + (size_t)(h * 64 + q) * M + tokbase + key0 + 8 * hi;
        bf16x8 vf[2][4];
#pragma unroll
        for (int db = 0; db < 2; ++db)
#pragma unroll
            for (int g = 0; g < 4; ++g) vf[db][g] = *(const bf16x8*)(vp + (size_t)db * 32 * M + g * 16);
        f32x16 s[2]; s[0] = f32x16{}; s[1] = f32x16{};
#pragma unroll
        for (int d0 = 0; d0 < 4; ++d0) { s[0] = __builtin_amdgcn_mfma_f32_32x32x16_bf16(kf[0][d0], qf[d0], s[0], 0, 0, 0); s[1] = __builtin_amdgcn_mfma_f32_32x32x16_bf16(kf[1][d0], qf[d0], s[1], 0, 0, 0); }
        float T[4];
#pragma unroll
        for (int rho = 0; rho < 4; ++rho) {
            float run = 0.f;
#pragma unroll
            for (int i = 7; i >= 0; --i) {
                const int r = 8 * (rho & 1) + i;
                const float z = s[rho >> 1][r] * L2E;
                const float t = __builtin_amdgcn_exp2f(-fabsf(z));
                const float L = __builtin_amdgcn_logf(1.0f + t);
                float lb = fminf(z, 0.f) - L, l1 = fminf(-z, 0.f) - L;
                if (diag) { const int key = key0 + 32 * (rho >> 1) + 16 * (rho & 1) + 8 * hi + i; const bool strict = key < qpos; l1 = strict ? l1 : 0.f; lb = strict ? lb : -INFINITY; }
                s[rho >> 1][r] = lb + run;
                run += l1;
            }
            T[rho] = run;
        }
        float P[4];
#pragma unroll
        for (int rho = 0; rho < 4; ++rho) P[rho] = __shfl_xor(T[rho], 32);
        const float t3 = T[3] + P[3], t2 = T[2] + P[2], t1 = T[1] + P[1], t0 = T[0] + P[0];
        float E[4]; E[3] = 0.f; E[2] = t3; E[1] = t3 + t2; E[0] = E[1] + t1;
        const float tot = E[0] + t0;
#pragma unroll
        for (int rho = 0; rho < 4; ++rho) E[rho] += carry + (hi == 0 ? P[rho] : 0.f);
        carry += tot;
#pragma unroll
        for (int rho = 0; rho < 4; ++rho)
#pragma unroll
            for (int i = 0; i < 8; ++i) { const int r = 8 * (rho & 1) + i; s[rho >> 1][r] = __builtin_amdgcn_exp2f(s[rho >> 1][r] + E[rho]); }
#pragma unroll
        for (int g = 0; g < 4; ++g) { const int blk = g >> 1, r0 = 8 * (g & 1);
            u32x4 pw; pw.x = cvtpk(s[blk][r0], s[blk][r0 + 1]); pw.y = cvtpk(s[blk][r0 + 2], s[blk][r0 + 3]); pw.z = cvtpk(s[blk][r0 + 4], s[blk][r0 + 5]); pw.w = cvtpk(s[blk][r0 + 6], s[blk][r0 + 7]);
            const bf16x8 pf = __builtin_bit_cast(bf16x8, pw);
            o[0] = __builtin_amdgcn_mfma_f32_32x32x16_bf16(vf[0][g], pf, o[0], 0, 0, 0);
            o[1] = __builtin_amdgcn_mfma_f32_32x32x16_bf16(vf[1][g], pf, o[1], 0, 0, 0); }
        if (__all(carry < -160.f)) break;
    }
    const size_t tok = tokbase + qpos;
#pragma unroll
    for (int db = 0; db < 2; ++db)
#pragma unroll
        for (int c = 0; c < 4; ++c) { const int d = 32 * db + 8 * c + 4 * hi;
            const u32x2 g = *(const u32x2*)(Gsb + tok * 512 + h * 64 + d);
            u32x2 w; w.x = cvtpk(o[db][4 * c] * bflo(g.x), o[db][4 * c + 1] * bfhi(g.x)); w.y = cvtpk(o[db][4 * c + 2] * bflo(g.y), o[db][4 * c + 3] * bfhi(g.y));
            *(u32x2*)(Acat + tok * 1024 + h * 64 + d) = w; }
}

constexpr int MLA_KPITCH = 208, MLA_VPITCH = 144, MLA_KBUF = 64 * MLA_KPITCH, MLA_VBUF = 64 * MLA_VPITCH, MLA_VOFF = 2 * MLA_KBUF;
__device__ __forceinline__ void mla_unit(int b, int h, int qb, const bf16* __restrict__ Qm, const bf16* __restrict__ Km, const bf16* __restrict__ Vt, const bf16* __restrict__ Gm, bf16* __restrict__ Acat, LAS unsigned char* lds) {
    const int tid = threadIdx.x, lane = tid & 63, wid = __builtin_amdgcn_readfirstlane(tid >> 6), q = lane & 31, hi = lane >> 5;
    const int q0 = qb * 256 + wid * 32;
    const size_t tokbase = (size_t)b * SEQ;
    const bf16* Qbh = Qm + (size_t)((b * 8 + h) * SEQ) * 96;
    const char* Kbh = (const char*)(Km + (size_t)((b * 8 + h) * SEQ) * 96);
    const char* Vbh = (const char*)(Vt + (size_t)(h * 64) * M + tokbase);
    bf16x8 qf[6];
#pragma unroll
    for (int d0 = 0; d0 < 6; ++d0) qf[d0] = *(const bf16x8*)(Qbh + (size_t)(q0 + q) * 96 + d0 * 16 + hi * 8);
    const int NT = 4 * qb + 4, NTw = 4 * qb + (wid >> 1) + 1;
    const int kc0 = tid, kc1 = 512 + tid;
    const int klds0 = (kc0 / 12) * MLA_KPITCH + (kc0 % 12) * 16, klds1 = (kc1 / 12) * MLA_KPITCH + (kc1 % 12) * 16;
    const int vrow = tid >> 3, vc16 = tid & 7;
    const int vlds = MLA_VOFF + vrow * MLA_VPITCH + vc16 * 16;
    const char* vsrc = Vbh + (size_t)vrow * M * 2 + vc16 * 16;
    const bool k1 = tid < 256;
    u32x4 rk0, rk1 = (u32x4){0u, 0u, 0u, 0u}, rv;
    rk0 = *(const u32x4*)(Kbh + kc0 * 16); if (k1) rk1 = *(const u32x4*)(Kbh + kc1 * 16); rv = *(const u32x4*)(vsrc);
    *(LAS u32x4*)(lds + klds0) = rk0; if (k1) *(LAS u32x4*)(lds + klds1) = rk1; *(LAS u32x4*)(lds + vlds) = rv;
    __syncthreads();
    const int krd = swap23(q) * MLA_KPITCH + hi * 16;
    const int vrd = MLA_VOFF + q * MLA_VPITCH + hi * 16;
    f32x16 o[2]; o[0] = f32x16{}; o[1] = f32x16{};
    float mrun = -1e30f, lrun = 0.f;
    for (int t = 0; t < NT; ++t) {
        const int cur = t & 1, nxt = cur ^ 1;
        const bool more = (t + 1 < NT);
        if (more) { const char* kg = Kbh + (size_t)(t + 1) * 64 * 192; rk0 = *(const u32x4*)(kg + kc0 * 16); if (k1) rk1 = *(const u32x4*)(kg + kc1 * 16); rv = *(const u32x4*)(vsrc + (size_t)(t + 1) * 128); }
        if (t < NTw) {
            LAS const unsigned char* kb = lds + cur * MLA_KBUF + krd;
            f32x16 s[2]; s[0] = f32x16{}; s[1] = f32x16{};
#pragma unroll
            for (int d0 = 0; d0 < 6; ++d0) {
                const bf16x8 k0 = *(LAS const bf16x8*)(kb + d0 * 32), k1f = *(LAS const bf16x8*)(kb + 32 * MLA_KPITCH + d0 * 32);
                s[0] = __builtin_amdgcn_mfma_f32_32x32x16_bf16(k0, qf[d0], s[0], 0, 0, 0);
                s[1] = __builtin_amdgcn_mfma_f32_32x32x16_bf16(k1f, qf[d0], s[1], 0, 0, 0); }
            float mx = fmaxf(s[0][0], s[1][0]);
#pragma unroll
            for (int r = 1; r < 16; ++r) mx = fmaxf(mx, fmaxf(s[0][r], s[1][r]));
            mx = fmaxf(mx, __shfl_xor(mx, 32));
            const float mnew = fmaxf(mrun, mx), alpha = __builtin_amdgcn_exp2f(mrun - mnew);
            mrun = mnew;
            float ls = 0.f;
#pragma unroll
            for (int r = 0; r < 16; ++r) { s[0][r] = __builtin_amdgcn_exp2f(s[0][r] - mnew); s[1][r] = __builtin_amdgcn_exp2f(s[1][r] - mnew); ls += s[0][r] + s[1][r]; }
            lrun = lrun * alpha + ls;
            o[0] = o[0] * alpha; o[1] = o[1] * alpha;
            LAS const unsigned char* vb = lds + cur * MLA_VBUF + vrd;
#pragma unroll
            for (int g = 0; g < 4; ++g) { const int blk = g >> 1, r0 = 8 * (g & 1);
                u32x4 pw; pw.x = cvtpk(s[blk][r0], s[blk][r0 + 1]); pw.y = cvtpk(s[blk][r0 + 2], s[blk][r0 + 3]); pw.z = cvtpk(s[blk][r0 + 4], s[blk][r0 + 5]); pw.w = cvtpk(s[blk][r0 + 6], s[blk][r0 + 7]);
                const bf16x8 pf = __builtin_bit_cast(bf16x8, pw);
                const bf16x8 v0 = *(LAS const bf16x8*)(vb + g * 32), v1 = *(LAS const bf16x8*)(vb + 32 * MLA_VPITCH + g * 32);
                o[0] = __builtin_amdgcn_mfma_f32_32x32x16_bf16(v0, pf, o[0], 0, 0, 0);
                o[1] = __builtin_amdgcn_mfma_f32_32x32x16_bf16(v1, pf, o[1], 0, 0, 0); }
        }
        if (more) { *(LAS u32x4*)(lds + nxt * MLA_KBUF + klds0) = rk0; if (k1) *(LAS u32x4*)(lds + nxt * MLA_KBUF + klds1) = rk1; *(LAS u32x4*)(lds + nxt * MLA_VBUF + vlds) = rv; }
        __syncthreads();
    }
    const float l = lrun + __shfl_xor(lrun, 32), inv = 1.0f / l;
    const size_t tok = tokbase + q0 + q;
#pragma unroll
    for (int db = 0; db < 2; ++db)
#pragma unroll
        for (int c = 0; c < 4; ++c) { const int d = 32 * db + 8 * c + 4 * hi;
            const u32x2 g = *(const u32x2*)(Gm + tok * 512 + h * 64 + d);
            u32x2 w; w.x = cvtpk(o[db][4 * c] * inv * bflo(g.x), o[db][4 * c + 1] * inv * bfhi(g.x)); w.y = cvtpk(o[db][4 * c + 2] * inv * bflo(g.y), o[db][4 * c + 3] * inv * bfhi(g.y));
            *(u32x2*)(Acat + tok * 1024 + 512 + h * 64 + d) = w; }
}

#define XB_TMO      128
#define XB_XCNT(j)  (256  + 64 * (j))
#define XB_XSUB(j)  (1280 + 64 * (j))
#define XB_XGEN(j)  (2304 + 64 * (j))
#define XB_TOP      3328
#define XB_TOPGEN   3392
#define XCD_BAR_WORDS 3456
#define XB_SPIN_CAP (1u << 18)

__device__ __forceinline__ unsigned xb_ld(unsigned* p)              { return __hip_atomic_load(p, __ATOMIC_RELAXED, __HIP_MEMORY_SCOPE_AGENT); }
__device__ __forceinline__ unsigned xb_add(unsigned* p, unsigned v) { return __hip_atomic_fetch_add(p, v, __ATOMIC_RELAXED, __HIP_MEMORY_SCOPE_AGENT); }
__device__ __forceinline__ unsigned xb_xcc_id() { return (unsigned)__builtin_amdgcn_s_getreg((3 << 11) | 20) & 0xFu; }
#define XB_SPIN(cond, bar) do { unsigned _sp = 0; while (cond) { __builtin_amdgcn_s_sleep(1); \
    if ((++_sp & 255u) == 0u) { if (xb_ld(&(bar)[XB_TMO])) break; if (_sp > XB_SPIN_CAP) { atomicAdd(&(bar)[XB_TMO], 1u); break; } } } } while (0)

struct XcdBarrier {
    unsigned* bar; unsigned x;
    volatile LAS unsigned* st;
};

__device__ __forceinline__ XcdBarrier xcd_barrier_post(unsigned* bar, volatile LAS unsigned* st) {
    XcdBarrier b; b.bar = bar; b.x = xb_xcc_id(); b.st = st;
    if (threadIdx.x == 0) (void)xb_add(&bar[XB_XCNT(b.x)], 1u);
    return b;
}
__device__ __forceinline__ void xcd_barrier_complete(unsigned* bar, unsigned x, unsigned& nloc, unsigned& nx) {
    const unsigned G = gridDim.x * gridDim.y * gridDim.z;
    unsigned sum, cnt, mine, sp = 0u;
    for (;;) {
        sum = 0u; cnt = 0u; mine = 0u;
#pragma unroll
        for (unsigned j = 0; j < 16; ++j) { const unsigned c = xb_ld(&bar[XB_XCNT(j)]); sum += c; cnt += (c > 0u) ? 1u : 0u; mine = (j == x) ? c : mine; }
        if (sum == G) break;
        __builtin_amdgcn_s_sleep(1);
        if ((++sp & 255u) == 0u) { if (xb_ld(&bar[XB_TMO])) break; if (sp > XB_SPIN_CAP) { atomicAdd(&bar[XB_TMO], 1u); break; } }
    }
    nloc = mine > 0u ? mine : 1u; nx = cnt > 0u ? cnt : 1u;
}

__device__ __forceinline__ void xcd_barrier(const XcdBarrier& b) {
    asm volatile("s_waitcnt vmcnt(0)" ::: "memory");
    __syncthreads();
    if (threadIdx.x == 0) {
        unsigned* bar = b.bar;
        __builtin_amdgcn_s_waitcnt(0);
        unsigned nloc = b.st[0], nx = b.st[1];
        if (nloc == 0u) { xcd_barrier_complete(bar, b.x, nloc, nx); b.st[0] = nloc; b.st[1] = nx; }
        const unsigned old = xb_add(&bar[XB_XSUB(b.x)], 1u);
        const unsigned gen = old / nloc;
        if (old + 1u == (gen + 1u) * nloc) {
            __builtin_amdgcn_fence(__ATOMIC_RELEASE, "agent");
            asm volatile("s_waitcnt vmcnt(0)" ::: "memory");
            const unsigned og = xb_add(&bar[XB_TOP], 1u);
            const unsigned tg = og / nx;
            if (og + 1u == (tg + 1u) * nx) xb_add(&bar[XB_TOPGEN], 1u);
            else XB_SPIN(xb_ld(&bar[XB_TOPGEN]) == tg, bar);
            __builtin_amdgcn_fence(__ATOMIC_ACQUIRE, "agent");
            xb_add(&bar[XB_XGEN(b.x)], 1u);
            asm volatile("s_waitcnt vmcnt(0)" ::: "memory");
        } else {
            XB_SPIN(xb_ld(&bar[XB_XGEN(b.x)]) == gen, bar);
            __builtin_amdgcn_fence(__ATOMIC_ACQUIRE, "agent");
            asm volatile("s_waitcnt vmcnt(0)" ::: "memory");
        }
    }
    __syncthreads();
}

struct Args { const float* in[12]; float* out; unsigned char* ws; int ph_lo, ph_hi; };

__global__ void __launch_bounds__(NTHREADS, 2) fwd_kernel(Args args) {
    extern __shared__ __attribute__((aligned(16))) unsigned char lds_raw[];
    LAS unsigned char* lds = (LAS unsigned char*)lds_raw;
    const int tid = threadIdx.x, lane = tid & 63, wave = __builtin_amdgcn_readfirstlane(tid >> 6);
    const int G = gridDim.x, bx = blockIdx.x;
    const int vcu = (G % 8 == 0) ? (bx % 8) * (G / 8) + bx / 8 : bx;
    const int gw = vcu * NWAVES + wave, NGW = G * NWAVES;
    unsigned char* ws = args.ws;
    const float* x = args.in[0];
    float* rowsq = (float*)(ws + WS_ROWSQ); float* cosT = (float*)(ws + WS_COS); float* sinT = (float*)(ws + WS_SIN);
    bf16 *Bt1 = (bf16*)(ws + WS_BT1), *Bt2a = (bf16*)(ws + WS_BT2A), *Bt2b = (bf16*)(ws + WS_BT2B), *Bt2c = (bf16*)(ws + WS_BT2C), *Bt4 = (bf16*)(ws + WS_BT4), *Bt5 = (bf16*)(ws + WS_BT5);
    float* Krope = (float*)(ws + WS_KROPE);
    bf16 *H = (bf16*)(ws + WS_H), *Acat = (bf16*)(ws + WS_ACAT), *Qsb = (bf16*)(ws + WS_QSB), *Ksb = (bf16*)(ws + WS_KSB), *VtSb = (bf16*)(ws + WS_VTSB), *Gsb = (bf16*)(ws + WS_GSB), *Merged = (bf16*)(ws + WS_MERGED);
    bf16 *Gmla = (bf16*)(ws + WS_GMLA), *Cq = (bf16*)(ws + WS_CQ), *Ckv = (bf16*)(ws + WS_CKV), *Cqn = (bf16*)(ws + WS_CQN), *Ckvn = (bf16*)(ws + WS_CKVN);
    bf16 *Qm = (bf16*)(ws + WS_QM), *Km = (bf16*)(ws + WS_KM), *VtM = (bf16*)(ws + WS_VTM);
    bf16* Gg = (bf16*)(ws + WS_G);
    const int lo = args.ph_lo, hi = args.ph_hi;
#ifndef PHMASK
#define PHMASK 0xff
#endif
#ifdef DBG_PROBE
#define IN(k) ((k) <= DBG_PROBE && lo <= (k) && (k) < hi)
#else
#define IN(k) (((PHMASK >> (k)) & 1) && lo <= (k) && (k) < hi)
#endif
#ifndef REP_SYNC
#define REP_SYNC 1
#endif
#define SEAM(k) do { if (IN(k) && IN((k) + 1)) { xcd_barrier(bar); if ((k) == 2) for (int rep_ = 1; rep_ < REP_SYNC; ++rep_) xcd_barrier(bar); } } while (0)
    volatile LAS unsigned* MISC = (volatile LAS unsigned*)(lds + 131072 + 512);
    if (tid < 32) MISC[tid] = 0u;
    __syncthreads();
    XcdBarrier bar; bar.bar = (unsigned*)(ws + WS_BAR); bar.x = 0; bar.st = nullptr;
    if (hi - lo > 1) bar = xcd_barrier_post((unsigned*)(ws + WS_BAR), MISC + 8);
    if (lo < 0) cg::this_grid().sync();

#ifndef REP_P0
#define REP_P0 1
#endif
    if (IN(0)) for (int rep = 0; rep < REP_P0; ++rep) {
        const int gt = vcu * NTHREADS + tid, NGT = G * NTHREADS;
        for (int i = gt; i < M; i += NGT) rowsq[i] = 0.f;
        for (int i = gt; i < SEQ * 16; i += NGT) { const int pos = i >> 4, k = i & 15;
            const float inv_freq = (float)pow(10000.0, -(double)k / 16.0);
            const float ang = (float)pos * inv_freq;
            const double rev = (double)ang * 0.15915494309189535; const float fr = (float)(rev - rint(rev));
            cosT[i] = __builtin_amdgcn_cosf(fr); sinT[i] = __builtin_amdgcn_sinf(fr); }
        LAS float* scr = (LAS float*)(lds + wave * 16384);
        constexpr int I1 = 16 * (N1 / 32), I2A = 6 * 24, I2B = 4 * 16, I2C = 4 * 16, I4A = 8 * 32, I4B = 8 * 32, I5 = 16 * 32;
        constexpr int NITEMS = I1 + I2A + I2B + I2C + I4A + I4B + I5;
        for (int it = gw; it < NITEMS; it += NGW) {
            int r = it;
            if (r < I1) { p0_transpose_item<1>(args.in[2], IN_COLS, Bt1, 1024, 0, N1 / 32, scr, r, lane); continue; } r -= I1;
            if (r < I2A) { p0_transpose_item<2>(args.in[5], 768, Bt2a, 384, 0, 24, scr, r, lane); continue; } r -= I2A;
            if (r < I2B) { p0_transpose_item<3>(args.in[7], 1024, Bt2b, 256, 0, 16, scr, r, lane); continue; } r -= I2B;
            if (r < I2C) { p0_transpose_item<4>(args.in[7], 1024, Bt2c, 256, 0, 16, scr, r, lane); continue; } r -= I2C;
            if (r < I4A) { p0_transpose_item<0>(args.in[8], 1024, Bt4, 1024, 0, 32, scr, r, lane); continue; } r -= I4A;
            if (r < I4B) { p0_transpose_item<0>(args.in[9], 1024, Bt4, 1024, 512, 32, scr, r, lane); continue; } r -= I4B;
            p0_transpose_item<0>(args.in[10], 1024, Bt5, 1024, 0, 32, scr, r, lane);
        }
        const float* gin = args.in[1];
        f32x4 gv[4];
#pragma unroll
        for (int j = 0; j < 4; ++j) gv[j] = *(const f32x4*)(gin + 256 * j + 4 * lane);
        for (int m = gw; m < M; m += NGW) {
            const f32x4* xr = (const f32x4*)(x + (size_t)m * DM) + lane;
            f32x4 v[4]; float s = 0.f;
#pragma unroll
            for (int j = 0; j < 4; ++j) { v[j] = xr[64 * j]; s += (v[j].x * v[j].x + v[j].y * v[j].y) + (v[j].z * v[j].z + v[j].w * v[j].w); }
            const float inv = 1.0f / sqrtf(wave_sum(s) * (1.f / DM) + EPS);
            u32x2* o8 = (u32x2*)(H + (size_t)m * DM) + lane;
#pragma unroll
            for (int j = 0; j < 4; ++j) { u32x2 w; w.x = cvtpk(v[j].x * inv * gv[j].x, v[j].y * inv * gv[j].y); w.y = cvtpk(v[j].z * inv * gv[j].z, v[j].w * inv * gv[j].w); o8[64 * j] = w; }
        }
    }
    SEAM(0);

#ifndef REP_P1
#define REP_P1 1
#endif
    if (IN(1)) for (int rep = 0; rep < REP_P1; ++rep) {
        { pg8::Gemm g{H, Bt1, M, N1A, DM}; pg8::StaticOrder S; S.init(M, N1A, G, bx);
          pg8::Epi1 E{Qsb, Ksb, Gsb, Cq, Ckv, Gmla, Gg, Krope, args.in[3]};
          pg8::gemm_phase<pg8::Epi1, pg8::StaticOrder, true, true>(lds, g, S, E); }
        { pg8::Gemm g{Bt1 + (size_t)N1A * DM, H, 512, M, DM}; pg8::StaticOrder S; S.init(512, M, G, (bx + G - 192 % G) % G);
          pg8::EpiPlain E{VtSb, M};
          pg8::gemm_phase<pg8::EpiPlain, pg8::StaticOrder, true, true>(lds, g, S, E); }
    }
    SEAM(1);

#ifndef REP_P2
#define REP_P2 1
#endif
    if (IN(2)) for (int rep = 0; rep < REP_P2; ++rep) {
        const float* gq = args.in[4]; const float* gkv = args.in[6];
        float gqa[3], gqb[3], gka[2], gkb[2];
#pragma unroll
        for (int i = 0; i < 3; ++i) { gqa[i] = gq[128 * i + 2 * lane]; gqb[i] = gq[128 * i + 2 * lane + 1]; }
#pragma unroll
        for (int i = 0; i < 2; ++i) { gka[i] = gkv[128 * i + 2 * lane]; gkb[i] = gkv[128 * i + 2 * lane + 1]; }
        for (int m = gw; m < M; m += NGW) {
            const int b = m >> 13, s = m & 8191;
            const unsigned* cq = (const unsigned*)(Cq + (size_t)m * 384) + lane; unsigned w[3]; float ss = 0.f;
#pragma unroll
            for (int i = 0; i < 3; ++i) { w[i] = cq[64 * i]; const float a = bflo(w[i]), c = bfhi(w[i]); ss += a * a + c * c; }
            float inv = 1.0f / sqrtf(wave_sum(ss) * (1.f / 384.f) + EPS);
            unsigned* oq = (unsigned*)(Cqn + (size_t)m * 384) + lane;
#pragma unroll
            for (int i = 0; i < 3; ++i) oq[64 * i] = cvtpk(bflo(w[i]) * inv * gqa[i], bfhi(w[i]) * inv * gqb[i]);
            const unsigned* ck = (const unsigned*)(Ckv + (size_t)m * 256) + lane; unsigned wk[2]; ss = 0.f;
#pragma unroll
            for (int i = 0; i < 2; ++i) { wk[i] = ck[64 * i]; const float a = bflo(wk[i]), c = bfhi(wk[i]); ss += a * a + c * c; }
            inv = 1.0f / sqrtf(wave_sum(ss) * (1.f / 256.f) + EPS);
            unsigned* ok = (unsigned*)(Ckvn + (size_t)m * 256) + lane;
#pragma unroll
            for (int i = 0; i < 2; ++i) ok[64 * i] = cvtpk(bflo(wk[i]) * inv * gka[i], bfhi(wk[i]) * inv * gkb[i]);
            const int hh = lane >> 3, jj = lane & 7;
            const f32x2 x1 = *(const f32x2*)(Krope + (size_t)m * 32 + 2 * jj), x2 = *(const f32x2*)(Krope + (size_t)m * 32 + 16 + 2 * jj);
            const f32x2 c2 = *(const f32x2*)(cosT + s * 16 + 2 * jj), s2 = *(const f32x2*)(sinT + s * 16 + 2 * jj);
            const f32x2 o1 = x1 * c2 - x2 * s2, o2 = x1 * s2 + x2 * c2;
            bf16* kd = Km + ((size_t)((b * 8 + hh) * SEQ + s)) * 96 + 64 + 2 * jj;
            *(unsigned*)kd = cvtpk(o1.x, o1.y); *(unsigned*)(kd + 16) = cvtpk(o2.x, o2.y);
        }
    }
    SEAM(2);

#ifndef REP_P3
#define REP_P3 1
#endif
    if (IN(3)) for (int rep = 0; rep < REP_P3; ++rep) {
        { pg8::Gemm g{Cqn, Bt2a, M, 768, 384}; pg8::StaticOrder S; S.init(M, 768, G, bx);
          pg8::Epi2a E{Qm, cosT, sinT, 0.10206207261596577f * L2E};
          pg8::gemm_phase<pg8::Epi2a, pg8::StaticOrder, true, true>(lds, g, S, E); }
        { pg8::Gemm g{Ckvn, Bt2b, M, 512, 256}; pg8::StaticOrder S; S.init(M, 512, G, (bx + G - 192 % G) % G);
          pg8::Epi2b E{Km};
          pg8::gemm_phase<pg8::Epi2b, pg8::StaticOrder, true, true>(lds, g, S, E); }
        { pg8::Gemm g{Bt2c, Ckvn, 512, M, 256}; pg8::StaticOrder S; S.init(512, M, G, (bx + G - 64 % G) % G);
          pg8::EpiPlain E{VtM, M};
          pg8::gemm_phase<pg8::EpiPlain, pg8::StaticOrder, true, true>(lds, g, S, E); }
    }
    SEAM(3);

    if (IN(4)) {
#ifndef REP_SB
#define REP_SB 1
#endif
#ifndef REP_MLA
#define REP_MLA 1
#endif
        for (int rep = 0; rep < REP_SB; ++rep)
        for (int task = gw; task < 16 * 256; task += NGW) { const int bh = task >> 8, j = task & 255; sb_task(bh >> 3, bh & 7, j, Qsb, Ksb, VtSb, Gsb, Acat, lane); }
        __syncthreads();
        for (int rep = 0; rep < REP_MLA; ++rep)
        for (int p = vcu; p < 256; p += G) { const int bh = p >> 4, sx = p & 15;
            mla_unit(bh >> 3, bh & 7, 31 - sx, Qm, Km, VtM, Gmla, Acat, lds);
            mla_unit(bh >> 3, bh & 7, sx, Qm, Km, VtM, Gmla, Acat, lds); }
    }
    SEAM(4);

#ifndef REP_P5
#define REP_P5 1
#endif
    if (IN(5)) for (int rep = 0; rep < REP_P5; ++rep) {
        pg8::Gemm g{Acat, Bt4, M, DM, DM}; pg8::StaticOrder S; S.init(M, DM, G, bx);
        pg8::Epi4 E{Gg, Merged};
        pg8::gemm_phase<pg8::Epi4, pg8::StaticOrder, true, true>(lds, g, S, E);
    }
    SEAM(5);

#ifndef REP_P6
#define REP_P6 1
#endif
    if (IN(6)) for (int rep = 0; rep < REP_P6; ++rep) {
        pg8::Gemm g{Merged, Bt5, M, DM, DM}; pg8::StaticOrder S; S.init(M, DM, G, bx);
        pg8::Epi5 E{x, args.out, rowsq};
        pg8::gemm_phase<pg8::Epi5, pg8::StaticOrder, true, true>(lds, g, S, E);
    }
    SEAM(6);

#ifdef DBG_PROBE
    if (lo <= 7 && 7 < hi) {
        const int gt = vcu * NTHREADS + tid, NGT = G * NTHREADS;
        for (size_t i = gt; i < (size_t)M * DM; i += NGT) {
            float v = 0.f;
#if DBG_PROBE == 3
            v += bflo(Qsb[i % ((size_t)M * 512)]) + bflo(Ksb[i % ((size_t)M * 512)]) * 2.f + bflo(VtSb[i % ((size_t)M * 512)]) * 3.f + bflo(Gsb[i % ((size_t)M * 512)]) * 4.f + bflo(Gmla[i % ((size_t)M * 512)]) * 5.f;
            v += bflo(Qm[i % ((size_t)M * 768)]) * 6.f + bflo(Km[i % ((size_t)M * 768)]) * 7.f + bflo(VtM[i % ((size_t)M * 512)]) * 8.f;
#elif DBG_PROBE == 1
            { const unsigned w = ((const unsigned*)Gg)[i]; v = bflo(w) + 3.f * bfhi(w); }
#elif DBG_PROBE == 4
            v += bflo(Acat[i]);
#elif DBG_PROBE == 5
            v += bflo(Merged[i]);
#endif
            args.out[i] = v;
        }
    }
#else
    if (IN(7)) {
        const float* gf = args.in[11];
        f32x4 gv[4];
#pragma unroll
        for (int j = 0; j < 4; ++j) gv[j] = *(const f32x4*)(gf + 256 * j + 4 * lane);
        for (int m = gw; m < M; m += NGW) {
            const float inv = 1.0f / sqrtf(rowsq[m] * (1.f / DM) + EPS);
            f32x4* xr = (f32x4*)(args.out + (size_t)m * DM) + lane;
#pragma unroll
#ifndef REP_P7
#define REP_P7 1
#endif
            for (int rep = 1; rep < REP_P7; ++rep) { _Pragma("unroll") for (int j = 0; j < 4; ++j) { f32x4 v = xr[64 * j]; asm volatile("" : "+v"(v)); xr[64 * j] = v; } }
            for (int j = 0; j < 4; ++j) { f32x4 v = xr[64 * j]; v = v * inv * gv[j]; xr[64 * j] = v; }
        }
    }
#endif
#undef IN
#undef SEAM
}

extern "C" void kernel_launch(void* const* d_in, const int* in_sizes, int n_in, void* d_out, int out_size, void* d_ws, size_t ws_size, hipStream_t stream) {
    static int grid = 0;
    if (grid == 0) {
        if (n_in != 12 || in_sizes[0] != M * DM || out_size != M * DM || ws_size < WS_END) { fprintf(stderr, "kernel_launch: unexpected shapes (n_in %d, in0 %d, out %d, ws %zu)\n", n_in, n_in > 0 ? in_sizes[0] : -1, out_size, ws_size); grid = -1; return; }
        int dev = 0, cus = 0, per_cu = 0;
        if (hipGetDevice(&dev) != hipSuccess || hipDeviceGetAttribute(&cus, hipDeviceAttributeMultiprocessorCount, dev) != hipSuccess) { grid = -1; return; }
        if (hipFuncSetAttribute((const void*)fwd_kernel, hipFuncAttributeMaxDynamicSharedMemorySize, LDS_BYTES) != hipSuccess) { fprintf(stderr, "kernel_launch: hipFuncSetAttribute failed\n"); grid = -1; return; }
        if (hipOccupancyMaxActiveBlocksPerMultiprocessor(&per_cu, (const void*)fwd_kernel, NTHREADS, LDS_BYTES) != hipSuccess || per_cu < 1) { fprintf(stderr, "kernel_launch: occupancy query says %d\n", per_cu); per_cu = 1; }
        (void)hipGetLastError();
        grid = cus * 1;
    }
    if (grid < 0) return;
    Args a{};
    for (int i = 0; i < 12; ++i) a.in[i] = (const float*)d_in[i];
    a.out = (float*)d_out; a.ws = (unsigned char*)d_ws;
#if MK_N_LAUNCHES == 1
    a.ph_lo = 0; a.ph_hi = N_PHASES;
    if (hipMemsetAsync((char*)d_ws + WS_BAR, 0, BAR_ZERO_BYTES, stream) != hipSuccess) { fprintf(stderr, "kernel_launch: hipMemsetAsync failed\n"); return; }
    void* kargs[] = {&a};
    hipError_t e = hipLaunchCooperativeKernel((const void*)fwd_kernel, dim3(grid), dim3(NTHREADS), kargs, LDS_BYTES, stream);
    if (e != hipSuccess) fprintf(stderr, "kernel_launch: cooperative launch failed: %s (grid %d)\n", hipGetErrorString(e), grid);
#else
    for (int p = 0; p < N_PHASES; ++p) { a.ph_lo = p; a.ph_hi = p + 1;
        hipLaunchKernelGGL(fwd_kernel, dim3(grid), dim3(NTHREADS), LDS_BYTES, stream, a);
        const hipError_t le = hipPeekAtLastError();
        if (le != hipSuccess) { fprintf(stderr, "kernel_launch: launch %d failed: %s\n", p, hipGetErrorName(le)); break; } }
#endif
}
```

```cpp
#include <hip/hip_runtime.h>
#include <hip/hip_cooperative_groups.h>
#include <cstdio>
#include <cstdint>
#include <cmath>
namespace cg = cooperative_groups;
namespace pg8 {
#define PG8_LAS __attribute__((address_space(3)))
typedef unsigned short bf16_t;
typedef short bf16x8 __attribute__((ext_vector_type(8)));
typedef float f32x4 __attribute__((ext_vector_type(4)));
typedef unsigned u32x4 __attribute__((ext_vector_type(4)));
constexpr int BM = 256, BK = 64, HALF = 128, HTB = HALF * BK * 2  , STAGE_BYTES = 8 * HTB, NXCD = 8, WGM = 8;

__host__ __device__ __forceinline__ int lds_byte(int r, int c) { const int st = (r >> 4) * 2 + (c >> 5), rr = r & 15, cc = c & 31, ob = rr * 64 + cc * 2; return st * 1024 + (ob ^ (((ob >> 9) & 1) << 5)); }
__host__ __device__ __forceinline__ void stage_rc(int b, int& R, int& C) { const int st = b / 1024, sb = b % 1024, swz = sb ^ (((sb >> 9) & 1) << 5); R = (st >> 1) * 16 + swz / 64; C = (st & 1) * 32 + (swz % 64) / 2; }
__host__ __device__ __forceinline__ int perm32(int rho) { const int n = rho >> 4, i = rho & 15; return 8 * (i >> 2) + 4 * n + (i & 3); }

struct Unit { int pm, pn; };
struct Gemm { const bf16_t* A; const bf16_t* Bt; int M, N, K; };

struct StaticOrder {
    int nM, nN, nwg, G, c;
    __host__ __device__ void init(int M, int N, int G_, int c_) { nM = M / BM; nN = N / BM; nwg = nM * nN; G = G_; c = c_; }
    __host__ __device__ bool next(int i, Unit& u) const {
        const long L = (long)i * G + c; if (L >= nwg) return false;
        int wgid = (int)L; { const int q = nwg / NXCD, r = nwg % NXCD, xcd = wgid % NXCD, off = wgid / NXCD; wgid = (xcd < r ? xcd * (q + 1) : r * (q + 1) + (xcd - r) * q) + off; }
        const int nig = WGM * nN, gid = wgid / nig, fm = gid * WGM, gsz = (nM - fm) < WGM ? (nM - fm) : WGM;
        u.pm = fm + ((wgid % nig) % gsz); u.pn = (wgid % nig) / gsz; return true;
    }
    __device__ __forceinline__ void a_ready(const Unit&) const {}
    __device__ __forceinline__ void done(const Unit&) const {}
};

typedef float f32x2_cv __attribute__((ext_vector_type(2))); typedef __bf16 bf16x2_cv __attribute__((ext_vector_type(2)));
__device__ __forceinline__ unsigned cvt_pk_bf16(float lo, float hi) { f32x2_cv v = {lo, hi}; bf16x2_cv b = __builtin_convertvector(v, bf16x2_cv); return __builtin_bit_cast(unsigned, b); }
typedef unsigned u32x2 __attribute__((ext_vector_type(2)));
__device__ __forceinline__ u32x4 pack8(f32x4 a, f32x4 b) { u32x4 w; w.x = cvt_pk_bf16(a[0], a[1]); w.y = cvt_pk_bf16(a[2], a[3]); w.z = cvt_pk_bf16(b[0], b[1]); w.w = cvt_pk_bf16(b[2], b[3]); return w; }
__device__ __forceinline__ u32x2 pack4(f32x4 a) { u32x2 w; w.x = cvt_pk_bf16(a[0], a[1]); w.y = cvt_pk_bf16(a[2], a[3]); return w; }
__device__ __forceinline__ void unpack8(u32x4 w, f32x4& a, f32x4& b) {
    a[0] = __uint_as_float(w.x << 16); a[1] = __uint_as_float(w.x & 0xffff0000u); a[2] = __uint_as_float(w.y << 16); a[3] = __uint_as_float(w.y & 0xffff0000u);
    b[0] = __uint_as_float(w.z << 16); b[1] = __uint_as_float(w.z & 0xffff0000u); b[2] = __uint_as_float(w.w << 16); b[3] = __uint_as_float(w.w & 0xffff0000u); }
__device__ __forceinline__ float sigmoid_fast(float v) { return __builtin_amdgcn_rcpf(1.0f + __builtin_amdgcn_exp2f(-1.4426950408889634f * v)); }

struct Epi1 {
    static constexpr bool PERM = true, AFTER_DRAIN = false, HAS_MID = false;
    bf16_t *Qsb, *Ksb, *Gsb, *Cq, *Ckv, *Gmla, *G; float* Krope; const float* bgate;
    template <int MODE> __device__ __forceinline__ void tile(const f32x4 (&acc)[2][2][4][2], bf16_t* base, int ld, int colt, float sc, int row0, int wc, int fq) const {
#pragma unroll
        for (int bj = 0; bj < 2; ++bj) { const int col = colt + bj * HALF + wc * 32 + 8 * fq;
            f32x4 b0 = (f32x4){0.f, 0.f, 0.f, 0.f}, b1 = b0;
#ifndef DBG_NOBIAS
            if (MODE == 2) { b0 = *(const f32x4*)(bgate + col); b1 = *(const f32x4*)(bgate + col + 4); }
#endif
#pragma unroll
            for (int ai = 0; ai < 2; ++ai)
#pragma unroll
                for (int m = 0; m < 4; ++m) { bf16_t* p = base + (size_t)(row0 + ai * HALF + m * 16) * ld + col;
                    f32x4 v0 = acc[ai][bj][m][0], v1 = acc[ai][bj][m][1];
                    if (MODE == 0) { v0 = v0 * sc; v1 = v1 * sc; }
                    else { v0 = v0 + b0; v1 = v1 + b1;
#pragma unroll
                        for (int e = 0; e < 4; ++e) { const float s0 = sigmoid_fast(v0[e]), s1 = sigmoid_fast(v1[e]); v0[e] = (MODE == 1) ? v0[e] * s0 : s0; v1[e] = (MODE == 1) ? v1[e] * s1 : s1; } }
                    *(u32x4*)p = pack8(v0, v1); } }
    }
    __device__ __forceinline__ void operator()(const f32x4 (&acc)[2][2][4][2], const Unit& u, int wr, int wc, int fr, int fq) const {
        asm volatile("" : "+v"(fr), "+v"(fq));
#ifdef DBG_ROT
        const int row0 = u.pm * BM + wr * 64 + fr, pn = (u.pn + 11) % 19;
#else
        const int row0 = u.pm * BM + wr * 64 + fr, pn = u.pn;
#endif
        if (pn < 2) tile<0>(acc, Qsb, 512, pn * 256, 0.125f, row0, wc, fq);
        else if (pn < 4) tile<0>(acc, Ksb, 512, (pn - 2) * 256, 1.f, row0, wc, fq);
        else if (pn < 6) tile<1>(acc, Gsb, 512, (pn - 4) * 256, 1.f, row0, wc, fq);
        else if (pn == 6) tile<0>(acc, Cq, 384, 0, 1.f, row0, wc, fq);
        else if (pn == 7) {
#pragma unroll
            for (int ai = 0; ai < 2; ++ai)
#pragma unroll
                for (int m = 0; m < 4; ++m) { const size_t row = (size_t)(row0 + ai * HALF + m * 16);
                    *(u32x4*)(Cq + row * 384 + 256 + wc * 32 + 8 * fq) = pack8(acc[ai][0][m][0], acc[ai][0][m][1]);
                    if (wc == 0) { float* kp = Krope + row * 32 + 8 * fq; *(f32x4*)kp = acc[ai][1][m][0]; *(f32x4*)(kp + 4) = acc[ai][1][m][1]; } }
        }
        else if (pn == 8) tile<0>(acc, Ckv, 256, 0, 1.f, row0, wc, fq);
        else if (pn < 11) tile<1>(acc, Gmla, 512, (pn - 9) * 256, 1.f, row0, wc, fq);
        else tile<2>(acc, G, 2048, (pn - 11) * 256, 1.f, row0, wc, fq);
    }
};
struct EpiPlain {
    static constexpr bool PERM = true, AFTER_DRAIN = false, HAS_MID = false;
    bf16_t* O; int ldc;
    __device__ __forceinline__ void operator()(const f32x4 (&acc)[2][2][4][2], const Unit& u, int wr, int wc, int fr, int fq) const {
        asm volatile("" : "+v"(fr), "+v"(fq));
        const int row0 = u.pm * BM + wr * 64 + fr, col0 = u.pn * BM + wc * 32 + 8 * fq;
#pragma unroll
        for (int ai = 0; ai < 2; ++ai)
#pragma unroll
            for (int m = 0; m < 4; ++m)
#pragma unroll
                for (int bj = 0; bj < 2; ++bj) *(u32x4*)(O + (size_t)(row0 + ai * HALF + m * 16) * ldc + col0 + bj * HALF) = pack8(acc[ai][bj][m][0], acc[ai][bj][m][1]);
    }
};
struct Epi2a {
    static constexpr bool PERM = true, AFTER_DRAIN = false, HAS_MID = false;
    bf16_t* Qm; const float* cosT; const float* sinT; float qs;
    __device__ __forceinline__ void operator()(const f32x4 (&acc)[2][2][4][2], const Unit& u, int wr, int wc, int fr, int fq) const {
        asm volatile("" : "+v"(fr), "+v"(fq));
        const int row0 = u.pm * BM + wr * 64 + fr;
        if (u.pn < 2) {
#pragma unroll
            for (int ai = 0; ai < 2; ++ai)
#pragma unroll
                for (int m = 0; m < 4; ++m) { const int row = row0 + ai * HALF + m * 16, b = row >> 13, s = row & 8191;
#pragma unroll
                    for (int bj = 0; bj < 2; ++bj) { const int col = u.pn * 256 + bj * HALF + wc * 32 + 8 * fq, h = col >> 6, d = col & 63;
                        *(u32x4*)(Qm + ((size_t)((b * 8 + h) * 8192 + s)) * 96 + d) = pack8(acc[ai][bj][m][0] * qs, acc[ai][bj][m][1] * qs); } }
        } else {
#pragma unroll
            for (int ai = 0; ai < 2; ++ai)
#pragma unroll
                for (int m = 0; m < 4; ++m) { const int row = row0 + ai * HALF + m * 16, b = row >> 13, s = row & 8191;
                    const f32x4 c4 = *(const f32x4*)(cosT + s * 16 + 4 * fq), s4 = *(const f32x4*)(sinT + s * 16 + 4 * fq);
#pragma unroll
                    for (int bj = 0; bj < 2; ++bj) { const int h = bj * 4 + wc; const f32x4 x1 = acc[ai][bj][m][0], x2 = acc[ai][bj][m][1];
                        const f32x4 o1 = (x1 * c4 - x2 * s4) * qs, o2 = (x1 * s4 + x2 * c4) * qs;
                        bf16_t* p = Qm + ((size_t)((b * 8 + h) * 8192 + s)) * 96 + 64 + 4 * fq;
                        *(u32x2*)p = pack4(o1); *(u32x2*)(p + 16) = pack4(o2); }
                    asm volatile("" ::: "memory"); }
        }
    }
};
struct Epi2b {
    static constexpr bool PERM = true, AFTER_DRAIN = false, HAS_MID = false;
    bf16_t* Km;
    __device__ __forceinline__ void operator()(const f32x4 (&acc)[2][2][4][2], const Unit& u, int wr, int wc, int fr, int fq) const {
        asm volatile("" : "+v"(fr), "+v"(fq));
        const int row0 = u.pm * BM + wr * 64 + fr;
#pragma unroll
        for (int ai = 0; ai < 2; ++ai)
#pragma unroll
            for (int m = 0; m < 4; ++m) { const int row = row0 + ai * HALF + m * 16, b = row >> 13, s = row & 8191;
#pragma unroll
                for (int bj = 0; bj < 2; ++bj) { const int col = u.pn * 256 + bj * HALF + wc * 32 + 8 * fq, h = col >> 6, d = col & 63;
                    *(u32x4*)(Km + ((size_t)((b * 8 + h) * 8192 + s)) * 96 + d) = pack8(acc[ai][bj][m][0], acc[ai][bj][m][1]); } }
    }
};
struct Epi4 {
    static constexpr bool PERM = true, AFTER_DRAIN = false, HAS_MID = true;
    const bf16_t* G; bf16_t* Mg;
    __device__ __forceinline__ void mid(f32x4 (&acc)[2][2][4][2], const Unit& u, int wr, int wc, int fr, int fq) const {
        asm volatile("" : "+v"(fr), "+v"(fq));
        const int row0 = u.pm * BM + wr * 64 + fr, col0 = u.pn * BM + wc * 32 + 8 * fq;
#pragma unroll
        for (int ai = 0; ai < 2; ++ai)
#pragma unroll
            for (int m = 0; m < 4; ++m)
#pragma unroll
                for (int bj = 0; bj < 2; ++bj) { const bf16_t* gp = G + (size_t)(row0 + ai * HALF + m * 16) * 2048 + col0 + bj * HALF;
                    f32x4 a0, a1, m0, m1; unpack8(*(const u32x4*)gp, a0, a1); unpack8(*(const u32x4*)(gp + 1024), m0, m1);
#pragma unroll
                    for (int e = 0; e < 4; ++e) { acc[ai][bj][m][0][e] *= a0[e] * __builtin_amdgcn_rcpf(fmaxf(m0[e], 1e-20f)); acc[ai][bj][m][1][e] *= a1[e] * __builtin_amdgcn_rcpf(fmaxf(m1[e], 1e-20f)); } }
    }
    __device__ __forceinline__ void operator()(const f32x4 (&acc)[2][2][4][2], const Unit& u, int wr, int wc, int fr, int fq) const {
        asm volatile("" : "+v"(fr), "+v"(fq));
        const int row0 = u.pm * BM + wr * 64 + fr, col0 = u.pn * BM + wc * 32 + 8 * fq;
#pragma unroll
        for (int ai = 0; ai < 2; ++ai)
#pragma unroll
            for (int m = 0; m < 4; ++m)
#pragma unroll
                for (int bj = 0; bj < 2; ++bj) { const size_t row = (size_t)(row0 + ai * HALF + m * 16); const int col = col0 + bj * HALF;
                    f32x4 m0, m1; unpack8(*(const u32x4*)(G + row * 2048 + 1024 + col), m0, m1);
                    f32x4 v0 = acc[ai][bj][m][0], v1 = acc[ai][bj][m][1];
#pragma unroll
                    for (int e = 0; e < 4; ++e) { v0[e] *= fmaxf(m0[e], 1e-20f); v1[e] *= fmaxf(m1[e], 1e-20f); }
                    *(u32x4*)(Mg + row * 1024 + col) = pack8(v0, v1); }
    }
};
struct Epi5 {
    static constexpr bool PERM = true, AFTER_DRAIN = false, HAS_MID = false;
    const float* X; float* Out; float* rowsq;
    __device__ __forceinline__ void operator()(const f32x4 (&acc)[2][2][4][2], const Unit& u, int wr, int wc, int fr, int fq) const {
        asm volatile("" : "+v"(fr), "+v"(fq));
        const int row0 = u.pm * BM + wr * 64 + fr, col0 = u.pn * BM + wc * 32 + 8 * fq;
#pragma unroll
        for (int ai = 0; ai < 2; ++ai)
#pragma unroll
            for (int m = 0; m < 4; ++m) { const size_t row = (size_t)(row0 + ai * HALF + m * 16); float ss = 0.f;
#pragma unroll
                for (int bj = 0; bj < 2; ++bj) { const size_t off = row * 1024 + col0 + bj * HALF;
                    const f32x4 v0 = *(const f32x4*)(X + off) + acc[ai][bj][m][0], v1 = *(const f32x4*)(X + off + 4) + acc[ai][bj][m][1];
                    *(f32x4*)(Out + off) = v0; *(f32x4*)(Out + off + 4) = v1;
                    ss += (v0[0] * v0[0] + v0[1] * v0[1]) + (v0[2] * v0[2] + v0[3] * v0[3]) + (v1[0] * v1[0] + v1[1] * v1[1]) + (v1[2] * v1[2] + v1[3] * v1[3]); }
                ss += __shfl_xor(ss, 16); ss += __shfl_xor(ss, 32);
#ifdef REP_P6
                ss *= (1.0f / REP_P6);
#endif
                if (fq == 0) atomicAdd(rowsq + row, ss); }
    }
};

template <class Epi, class Sched, bool ALIGN_EPI = false, bool SP2 = false>
__device__ __forceinline__ void gemm_phase(PG8_LAS unsigned char* lds, const Gemm g, const Sched& S, const Epi& E) {
    const int tid = threadIdx.x, wid = __builtin_amdgcn_readfirstlane(tid >> 6), lane = tid & 63, wr = wid >> 2, wc = wid & 3, fr = lane & 15, fq = lane >> 4;
    int K = g.K; asm volatile("" : "+s"(K));
    const int nt = K / BK;
    unsigned voffA[2], voffB[2];
#pragma unroll
    for (int i = 0; i < 2; ++i) { int R, C; stage_rc(tid * 16 + i * 8192, R, C); const int Rb = Epi::PERM ? ((R & ~31) + perm32(R & 31)) : R;
        voffA[i] = (unsigned)(R * K + C) * 2u; voffB[i] = (unsigned)(Rb * K + C) * 2u; }
    const size_t kstep = (size_t)(BK * 2);
    const size_t hstep = (size_t)HALF * K * 2;
    const size_t tstep = 2 * hstep;
    const unsigned ldsw = (unsigned)wid * 1024u;
    const int aoff = lds_byte(wr * 64 + fr, fq * 8), boff = lds_byte(wc * 32 + fr, fq * 8);
#define PG8_SA(b, h) (((b) * 2 + (h)) * HTB)
#define PG8_SB(b, h) ((4 + (b) * 2 + (h)) * HTB)
#define PG8_STAGE(bufoff, gbase, voff) do { _Pragma("unroll") for (int _i = 0; _i < 2; ++_i) \
        __builtin_amdgcn_global_load_lds((const unsigned*)((const char*)(gbase) + (voff)[_i]), (PG8_LAS unsigned*)(lds + (bufoff) + ldsw + _i * 8192), 16, 0, 0); } while (0)
#define PG8_LDA(dst, b, h) do { _Pragma("unroll") for (int m = 0; m < 4; ++m) _Pragma("unroll") for (int k = 0; k < 2; ++k) dst[m][k] = *(const PG8_LAS bf16x8*)(lds + PG8_SA(b, h) + aoff + m * 2048 + k * 1024); } while (0)
#define PG8_LDB(dst, b, h) do { _Pragma("unroll") for (int n = 0; n < 2; ++n) _Pragma("unroll") for (int k = 0; k < 2; ++k) dst[n][k] = *(const PG8_LAS bf16x8*)(lds + PG8_SB(b, h) + boff + n * 2048 + k * 1024); } while (0)
#define PG8_MMA(ai, bj, At, Bt) do { __builtin_amdgcn_s_setprio(1); _Pragma("unroll") for (int m = 0; m < 4; ++m) _Pragma("unroll") for (int n = 0; n < 2; ++n) _Pragma("unroll") for (int k = 0; k < 2; ++k) \
        acc[ai][bj][m][n] = __builtin_amdgcn_mfma_f32_16x16x32_bf16(Bt[n][k], At[m][k], acc[ai][bj][m][n], 0, 0, 0); __builtin_amdgcn_s_setprio(0); } while (0)
#define PG8_WAIT_V(n) asm volatile("s_waitcnt vmcnt(" #n ")" ::: "memory")
#define PG8_WAIT_L(n) asm volatile("s_waitcnt lgkmcnt(" #n ")" ::: "memory")
#define PG8_BAR __builtin_amdgcn_s_barrier()
#define PG8_SCHED __builtin_amdgcn_sched_barrier(0)
    Unit cur, nxt; int ui = 0;
    if (!S.next(0, cur)) return;
    f32x4 acc[2][2][4][2];
#pragma unroll
    for (int a = 0; a < 2; ++a)
#pragma unroll
        for (int b = 0; b < 2; ++b)
#pragma unroll
            for (int m = 0; m < 4; ++m)
#pragma unroll
                for (int n = 0; n < 2; ++n) acc[a][b][m][n] = (f32x4){0.f, 0.f, 0.f, 0.f};
    bf16x8 At[4][2], B0[2][2], B1[2][2];
    const char* cA = (const char*)g.A + (size_t)cur.pm * tstep; const char* cB = (const char*)g.Bt + (size_t)cur.pn * tstep;
    S.a_ready(cur);
    if constexpr (SP2) {
        PG8_STAGE(PG8_SB(0, 0), cB, voffB); PG8_STAGE(PG8_SB(0, 1), cB + hstep, voffB); PG8_STAGE(PG8_SA(0, 0), cA, voffA); PG8_STAGE(PG8_SA(0, 1), cA + hstep, voffA);
        if (wr == 1) PG8_BAR;
        PG8_WAIT_V(2); PG8_BAR;
        PG8_STAGE(PG8_SB(1, 0), cB + kstep, voffB); PG8_STAGE(PG8_SA(1, 0), cA + kstep, voffA); PG8_STAGE(PG8_SB(1, 1), cB + hstep + kstep, voffB);
        PG8_WAIT_V(6); PG8_BAR;
    } else {
        PG8_STAGE(PG8_SB(0, 0), cB, voffB); PG8_STAGE(PG8_SA(0, 0), cA, voffA); PG8_STAGE(PG8_SB(0, 1), cB + hstep, voffB); PG8_STAGE(PG8_SA(0, 1), cA + hstep, voffA);
        if (wr == 1) PG8_BAR;
        PG8_WAIT_V(4); PG8_BAR;
        PG8_STAGE(PG8_SB(1, 0), cB + kstep, voffB); PG8_STAGE(PG8_SA(1, 0), cA + kstep, voffA); PG8_STAGE(PG8_SB(1, 1), cB + hstep + kstep, voffB);
        PG8_WAIT_V(6); PG8_BAR;
    }
    for (;;) {
        const bool has_next = S.next(ui + 1, nxt);
        const char* nA = has_next ? (const char*)g.A + (size_t)nxt.pm * tstep : cA; const char* nB = has_next ? (const char*)g.Bt + (size_t)nxt.pn * tstep : cB;
        for (int t = 0; t < nt; t += 2) {
            if constexpr (Epi::HAS_MID) { if (t == nt / 2) E.mid(acc, cur, wr, wc, fr, fq); }
            const bool last = (t == nt - 2);
            const char* a1 = cA + (size_t)(t + 1) * kstep;
            const char* a2 = last ? nA : cA + (size_t)(t + 2) * kstep; const char* b2 = last ? nB : cB + (size_t)(t + 2) * kstep;
            const char* a3 = a2 + kstep; const char* b3 = b2 + kstep;
            if (last && has_next) S.a_ready(nxt);
            if constexpr (SP2) {
            PG8_LDB(B0, 0, 0); PG8_LDB(B1, 0, 1); PG8_SCHED; PG8_LDA(At, 0, 0); PG8_STAGE(PG8_SA(1, 1), a1 + hstep, voffA);
            PG8_WAIT_V(8); PG8_WAIT_L(0); PG8_BAR; PG8_MMA(0, 0, At, B0); PG8_MMA(0, 1, At, B1); PG8_BAR; PG8_SCHED;
            PG8_LDA(At, 0, 1); PG8_STAGE(PG8_SB(0, 0), b2, voffB); PG8_STAGE(PG8_SB(0, 1), b2 + hstep, voffB); PG8_STAGE(PG8_SA(0, 0), a2, voffA);
            PG8_WAIT_V(8); PG8_WAIT_L(0); PG8_BAR; PG8_MMA(1, 0, At, B0); PG8_MMA(1, 1, At, B1); PG8_BAR; PG8_SCHED;
            PG8_LDB(B0, 1, 0); PG8_LDB(B1, 1, 1); PG8_SCHED; PG8_LDA(At, 1, 0); PG8_STAGE(PG8_SA(0, 1), a2 + hstep, voffA);
            PG8_WAIT_V(8); PG8_WAIT_L(0); PG8_BAR; PG8_MMA(0, 0, At, B0); PG8_MMA(0, 1, At, B1); PG8_BAR; PG8_SCHED;
            PG8_LDA(At, 1, 1); PG8_STAGE(PG8_SB(1, 0), b3, voffB); PG8_STAGE(PG8_SB(1, 1), b3 + hstep, voffB); PG8_STAGE(PG8_SA(1, 0), a3, voffA);
            PG8_WAIT_V(8); PG8_WAIT_L(0); PG8_BAR; PG8_MMA(1, 0, At, B0); PG8_MMA(1, 1, At, B1); PG8_BAR; PG8_SCHED;
            } else {
            PG8_LDB(B0, 0, 0); PG8_SCHED; PG8_LDA(At, 0, 0); PG8_STAGE(PG8_SA(1, 1), a1 + hstep, voffA);
            PG8_WAIT_L(8); PG8_BAR; PG8_WAIT_L(0); PG8_MMA(0, 0, At, B0); PG8_BAR; PG8_SCHED;
            PG8_LDB(B1, 0, 1); PG8_STAGE(PG8_SB(0, 0), b2, voffB);
            PG8_BAR; PG8_WAIT_L(0); PG8_MMA(0, 1, At, B1); PG8_BAR;
            PG8_LDA(At, 0, 1); PG8_STAGE(PG8_SA(0, 0), a2, voffA);
            PG8_BAR; PG8_WAIT_L(0); PG8_MMA(1, 0, At, B0); PG8_BAR; PG8_SCHED;
            PG8_STAGE(PG8_SB(0, 1), b2 + hstep, voffB);
            PG8_WAIT_V(6); PG8_BAR; PG8_MMA(1, 1, At, B1); PG8_BAR;
            PG8_LDB(B0, 1, 0); PG8_SCHED; PG8_LDA(At, 1, 0); PG8_STAGE(PG8_SA(0, 1), a2 + hstep, voffA);
            PG8_WAIT_L(8); PG8_BAR; PG8_WAIT_L(0); PG8_MMA(0, 0, At, B0); PG8_BAR; PG8_SCHED;
            PG8_LDB(B1, 1, 1); PG8_STAGE(PG8_SB(1, 0), b3, voffB);
            PG8_BAR; PG8_WAIT_L(0); PG8_MMA(0, 1, At, B1); PG8_BAR;
            PG8_LDA(At, 1, 1); PG8_STAGE(PG8_SA(1, 0), a3, voffA);
            PG8_BAR; PG8_WAIT_L(0); PG8_MMA(1, 0, At, B0); PG8_BAR; PG8_SCHED;
            PG8_STAGE(PG8_SB(1, 1), b3 + hstep, voffB);
            PG8_WAIT_V(6); PG8_BAR; PG8_MMA(1, 1, At, B1); PG8_BAR;
            }
        }
        if constexpr (ALIGN_EPI) { if (wr == 0) PG8_BAR; }
        if constexpr (!Epi::AFTER_DRAIN) { E(acc, cur, wr, wc, fr, fq); S.done(cur); }
        if (!has_next) break;
#pragma unroll
        for (int a = 0; a < 2; ++a)
#pragma unroll
            for (int b = 0; b < 2; ++b)
#pragma unroll
                for (int m = 0; m < 4; ++m)
#pragma unroll
                    for (int n = 0; n < 2; ++n) acc[a][b][m][n] = (f32x4){0.f, 0.f, 0.f, 0.f};
        cur = nxt; cA = nA; cB = nB; ++ui;
        if constexpr (ALIGN_EPI) { if (wr == 1) PG8_BAR; }
    }
    PG8_WAIT_V(0);
    if constexpr (!ALIGN_EPI) { if (wr == 0) PG8_BAR; }
    PG8_BAR;
    if constexpr (Epi::AFTER_DRAIN) { E.fused(acc, cur, wr, wc, fr, fq, lds, wid, lane); S.done(cur); }
#undef PG8_SA
#undef PG8_SB
#undef PG8_STAGE
#undef PG8_LDA
#undef PG8_LDB
#undef PG8_MMA
#undef PG8_WAIT_V
#undef PG8_WAIT_L
#undef PG8_BAR
#undef PG8_SCHED
}
}

#define LAS __attribute__((address_space(3)))
typedef unsigned short bf16;
typedef short bf16x8 __attribute__((ext_vector_type(8)));
typedef float f32x4 __attribute__((ext_vector_type(4)));
typedef float f32x2 __attribute__((ext_vector_type(2)));
typedef float f32x16 __attribute__((ext_vector_type(16)));
typedef unsigned u32x4 __attribute__((ext_vector_type(4)));
typedef unsigned u32x2 __attribute__((ext_vector_type(2)));

constexpr int NWAVES = 8, NTHREADS = 512;
constexpr int BATCH = 2, SEQ = 8192, DM = 1024, M = BATCH * SEQ;
constexpr int IN_COLS = 5280;
constexpr float EPS = 1e-6f;
constexpr float L2E = 1.4426950408889634f;
constexpr int LDS_BYTES = 147456;
#ifndef MK_N_LAUNCHES
#define MK_N_LAUNCHES 1
#endif
constexpr int N_PHASES = 8;

constexpr size_t MiB = 1u << 20;
constexpr size_t KiB = 1u << 10;
constexpr size_t WS_BAR = 512 * KiB, BAR_ZERO_BYTES = 16 * KiB;
constexpr size_t WS_ROWSQ = 0, WS_BT4 = 1 * MiB, WS_BT5 = 3 * MiB, WS_COS = 5 * MiB, WS_SIN = 5 * MiB + 512 * KiB;
constexpr size_t WS_BT2A = 6 * MiB, WS_BT2B = 6 * MiB + 768 * KiB, WS_BT2C = 7 * MiB, WS_KROPE = 7 * MiB + 256 * KiB;
constexpr size_t WS_G = 10 * MiB;
constexpr size_t WS_QSB = 74 * MiB, WS_KSB = 90 * MiB, WS_VTSB = 106 * MiB, WS_GSB = 122 * MiB, WS_GMLA = 138 * MiB;
constexpr size_t WS_MERGED = 74 * MiB;
constexpr size_t WS_KM = 154 * MiB, WS_QM = 178 * MiB, WS_VTM = 202 * MiB, WS_ACAT = 218 * MiB;
constexpr size_t WS_BT1 = 154 * MiB;
constexpr size_t WS_CQ = 178 * MiB, WS_CKV = 190 * MiB;
constexpr size_t WS_H = 218 * MiB;
constexpr size_t WS_CQN = 218 * MiB, WS_CKVN = 230 * MiB;
constexpr size_t WS_END = 256 * MiB;
constexpr int N1A = 4864, N1 = 5376;

__device__ __forceinline__ float wave_sum(float v) {
#pragma unroll
    for (int o = 1; o < 64; o <<= 1) v += __shfl_xor(v, o);
    return v;
}
__device__ __forceinline__ unsigned cvtpk(float lo, float hi) { return pg8::cvt_pk_bf16(lo, hi); }
__device__ __forceinline__ float bflo(unsigned w) { return __uint_as_float(w << 16); }
__device__ __forceinline__ float bfhi(unsigned w) { return __uint_as_float(w & 0xffff0000u); }

__device__ __forceinline__ int map_w_in(int n) {
    if (n >= N1A) return 1024 + (n - N1A);
#ifdef DBG_ROT
    const int t = ((n >> 8) + 11) % 19, w = n & 255; n = t * 256 + w;
#else
    const int t = n >> 8, w = n & 255;
#endif
    if (t < 4) return n;
    if (t < 6) return 1536 + (n - 1024);
    if (t == 6) return 2048 + w;
    if (t == 7) return w < 128 ? 2304 + w : (w < 160 ? 2688 + (w - 128) : -1);
    if (t == 8) return 2432 + w;
    if (t < 11) return 2720 + (n - 9 * 256);
    return 3232 + (n - 11 * 256);
}
__device__ __forceinline__ int map_q_up(int n) {
    if (n < 512) return (n >> 6) * 96 + (n & 63);
    const int r = n - 512, h = r >> 5, p = r & 31, fq = p >> 3, half = (p >> 2) & 1, i = p & 3;
    return h * 96 + 64 + half * 16 + 4 * fq + i;
}
template <int MAP> __device__ __forceinline__ void p0_transpose_item(const float* W, int Nsrc, bf16* WT, int kpitch, int koff, int nblk, LAS float* scr, int item, int lane) {
    const int kb = item / nblk, nb = item % nblk, k0 = 64 * kb, n0 = 32 * nb;
    const int n = n0 + (lane & 31);
    int src;
    if (MAP == 0) src = n; else if (MAP == 1) src = map_w_in(n); else if (MAP == 2) src = map_q_up(n); else if (MAP == 3) src = (n >> 6) * 128 + (n & 63); else src = (n >> 6) * 128 + 64 + (n & 63);
#pragma unroll 8
    for (int i = 0; i < 32; ++i) { const int kk = 2 * i + (lane >> 5); scr[kk * 33 + (lane & 31)] = src >= 0 ? W[(size_t)(k0 + kk) * Nsrc + src] : 0.f; }
    asm volatile("s_waitcnt lgkmcnt(0)" ::: "memory");
    const int c = lane & 7;
#pragma unroll
    for (int j = 0; j < 4; ++j) { const int nn = (lane >> 3) + 8 * j; const LAS float* s = scr + (8 * c) * 33 + nn;
        u32x4 o; o.x = cvtpk(s[0 * 33], s[1 * 33]); o.y = cvtpk(s[2 * 33], s[3 * 33]); o.z = cvtpk(s[4 * 33], s[5 * 33]); o.w = cvtpk(s[6 * 33], s[7 * 33]);
        *(u32x4*)(WT + (size_t)(n0 + nn) * kpitch + koff + k0 + 8 * c) = o; }
    asm volatile("s_waitcnt lgkmcnt(0)" ::: "memory");
}

__device__ __forceinline__ int swap23(int m) { return (m & ~12) | ((m & 4) << 1) | ((m & 8) >> 1); }
__device__ __forceinline__ void sb_task(int b, int h, int j, const bf16* __restrict__ Qsb, const bf16* __restrict__ Ksb, const bf16* __restrict__ Vt, const bf16* __restrict__ Gsb, bf16* __restrict__ Acat, int lane) {
    const int q = lane & 31, hi = lane >> 5, q0 = 32 * j, qpos = q0 + q;
    const size_t tokbase = (size_t)b * SEQ;
    bf16x8 qf[4];
    { const bf16* qp = Qsb + (tokbase + q0 + q) * 512 + h * 64 + hi * 8;
#pragma unroll
      for (int d0 = 0; d0 < 4; ++d0) qf[d0] = *(const bf16x8*)(qp + d0 * 16); }
    f32x16 o[2]; o[0] = f32x16{}; o[1] = f32x16{};
    float carry = 0.f;
    const int krow = swap23(q);
    for (int kt = j >> 1; kt >= 0; --kt) {
        const int key0 = kt * 64;
        const bool diag = (kt == (j >> 1));
        const bf16* kp = Ksb + (tokbase + key0 + krow) * 512 + h * 64 + hi * 8;
        bf16x8 kf[2][4];
#pragma unroll
        for (int blk = 0; blk < 2; ++blk)
#pragma unroll
            for (int d0 = 0; d0 < 4; ++d0) kf[blk][d0] = *(const bf16x8*)(kp + (size_t)blk * 32 * 512 + d0 * 16);
        const bf16* vp = Vt + (size_t)(h * 64 + q) * M + tokbase + key0 + 8 * hi;
        bf16x8 vf[2][4];
#pragma unroll
        for (int db = 0; db < 2; ++db)
#pragma unroll
            for (int g = 0; g < 4; ++g) vf[db][g] = *(const bf16x8*)(vp + (size_t)db * 32 * M + g * 16);
        f32x16 s[2]; s[0] = f32x16{}; s[1] = f32x16{};
#pragma unroll
        for (int d0 = 0; d0 < 4; ++d0) { s[0] = __builtin_amdgcn_mfma_f32_32x32x16_bf16(kf[0][d0], qf[d0], s[0], 0, 0, 0); s[1] = __builtin_amdgcn_mfma_f32_32x32x16_bf16(kf[1][d0], qf[d0], s[1], 0, 0, 0); }
        float T[4];
#pragma unroll
        for (int rho = 0; rho < 4; ++rho) {
            float run = 0.f;
#pragma unroll
            for (int i = 7; i >= 0; --i) {
                const int r = 8 * (rho & 1) + i;
                const float z = s[rho >> 1][r] * L2E;
                const float t = __builtin_amdgcn_exp2f(-fabsf(z));
                const float L = __builtin_amdgcn_logf(1.0f + t);
                float lb = fminf(z, 0.f) - L, l1 = fminf(-z, 0.f) - L;
                if (diag) { const int key = key0 + 32 * (rho >> 1) + 16 * (rho & 1) + 8 * hi + i; const bool strict = key < qpos; l1 = strict ? l1 : 0.f; lb = strict ? lb : -INFINITY; }
                s[rho >> 1][r] = lb + run;
                run += l1;
            }
            T[rho] = run;
        }
        float P[4];
#pragma unroll
        for (int rho = 0; rho < 4; ++rho) P[rho] = __shfl_xor(T[rho], 32);
        const float t3 = T[3] + P[3], t2 = T[2] + P[2], t1 = T[1] + P[1], t0 = T[0] + P[0];
        float E[4]; E[3] = 0.f; E[2] = t3; E[1] = t3 + t2; E[0] = E[1] + t1;
        const float tot = E[0] + t0;
#pragma unroll
        for (int rho = 0; rho < 4; ++rho) E[rho] += carry + (hi == 0 ? P[rho] : 0.f);
        carry += tot;
#pragma unroll
        for (int rho = 0; rho < 4; ++rho)
#pragma unroll
            for (int i = 0; i < 8; ++i) { const int r = 8 * (rho & 1) + i; s[rho >> 1][r] = __builtin_amdgcn_exp2f(s[rho >> 1][r] + E[rho]); }
#pragma unroll
        for (int g = 0; g < 4; ++g) { const int blk = g >> 1, r0 = 8 * (g & 1);
            u32x4 pw; pw.x = cvtpk(s[blk][r0], s[blk][r0 + 1]); pw.y = cvtpk(s[blk][r0 + 2], s[blk][r0 + 3]); pw.z = cvtpk(s[blk][r0 + 4], s[blk][r0 + 5]); pw.w = cvtpk(s[blk][r0 + 6], s[blk][r0 + 7]);
            const bf16x8 pf = __builtin_bit_cast(bf16x8, pw);
            o[0] = __builtin_amdgcn_mfma_f32_32x32x16_bf16(vf[0][g], pf, o[0], 0, 0, 0);
            o[1] = __builtin_amdgcn_mfma_f32_32x32x16_bf16(vf[1][g], pf, o[1], 0, 0, 0); }
        if (__all(carry < -160.f)) break;
    }
    const size_t tok = tokbase + qpos;
#pragma unroll
    for (int db = 0; db < 2; ++db)
#pragma unroll
        for (int c = 0; c < 4; ++c) { const int d = 32 * db + 8 * c + 4 * hi;
            const u32x2 g = *(const u32x2*)(Gsb + tok * 512 + h * 64 + d);
            u32x2 w; w.x = cvtpk(o[db][4 * c] * bflo(g.x), o[db][4 * c + 1] * bfhi(g.x)); w.y = cvtpk(o[db][4 * c + 2] * bflo(g.y), o[db][4 * c + 3] * bfhi(g.y));
            *(u32x2*)(Acat + tok * 1024 + h * 64 + d) = w; }
}

constexpr int MLA_KPITCH = 208, MLA_VPITCH = 144, MLA_KBUF = 64 * MLA_KPITCH, MLA_VBUF = 64 * MLA_VPITCH, MLA_VOFF = 2 * MLA_KBUF;
#define MLA_SBAR() __builtin_amdgcn_sched_barrier(0)
#define MLA_MFMA(a, b, c) __builtin_amdgcn_mfma_f32_32x32x16_bf16(a, b, c, 0, 0, 0)
#define MLA_LDS(p) (*(LAS const bf16x8*)(p))
#define MLA_SC(e) (((e) < 16) ? sc0[(e) & 15] : sc1[(e) & 15])
__device__ __forceinline__ float fmax3(float a, float b, float c) { return fmaxf(fmaxf(a, b), c); }
__device__ __forceinline__ void mla_unit(int b, int h, int qb, const bf16* __restrict__ Qm, const bf16* __restrict__ Km, const bf16* __restrict__ Vt, const bf16* __restrict__ Gm, bf16* __restrict__ Acat, LAS unsigned char* lds) {
    const int tid = threadIdx.x, lane = tid & 63, wid = __builtin_amdgcn_readfirstlane(tid >> 6), q = lane & 31, hi = lane >> 5;
    const int q0 = qb * 256 + wid * 32;
    const size_t tokbase = (size_t)b * SEQ;
    const bf16* Qbh = Qm + (size_t)((b * 8 + h) * SEQ) * 96;
    const char* Kbh = (const char*)(Km + (size_t)((b * 8 + h) * SEQ) * 96);
    const char* Vbh = (const char*)(Vt + (size_t)(h * 64) * M + tokbase);
    bf16x8 qf[6];
#pragma unroll
    for (int d0 = 0; d0 < 6; ++d0) qf[d0] = *(const bf16x8*)(Qbh + (size_t)(q0 + q) * 96 + d0 * 16 + hi * 8);
    const int NT = 4 * qb + 4, NTw = 4 * qb + (wid >> 1) + 1;
    const int kc0 = tid, kc1 = 512 + tid;
    const int klds0 = (kc0 / 12) * MLA_KPITCH + (kc0 % 12) * 16, klds1 = (kc1 / 12) * MLA_KPITCH + (kc1 % 12) * 16;
    const int vrow = tid >> 3, vc16 = tid & 7;
    const int vlds = MLA_VOFF + vrow * MLA_VPITCH + vc16 * 16;
    const char* vsrc = Vbh + (size_t)vrow * M * 2 + vc16 * 16;
    const bool k1 = tid < 256;
    u32x4 rk0, rk1 = (u32x4){0u, 0u, 0u, 0u}, rv;
    {
        rk0 = *(const u32x4*)(Kbh + kc0 * 16); if (k1) rk1 = *(const u32x4*)(Kbh + kc1 * 16); rv = *(const u32x4*)(vsrc);
        u32x4 b0 = *(const u32x4*)(Kbh + 64 * 192 + kc0 * 16), b1 = (u32x4){0u, 0u, 0u, 0u}; if (k1) b1 = *(const u32x4*)(Kbh + 64 * 192 + kc1 * 16);
        *(LAS u32x4*)(lds + klds0) = rk0; if (k1) *(LAS u32x4*)(lds + klds1) = rk1; *(LAS u32x4*)(lds + vlds) = rv;
        *(LAS u32x4*)(lds + MLA_KBUF + klds0) = b0; if (k1) *(LAS u32x4*)(lds + MLA_KBUF + klds1) = b1;
    }
    __syncthreads();
    const int krd = swap23(q) * MLA_KPITCH + hi * 16;
    const int vrd = MLA_VOFF + q * MLA_VPITCH + hi * 16;
    f32x16 negm = f32x16{}; asm volatile("" : "+v"(negm));
    f32x16 sc0, sc1;
    {
        LAS const unsigned char* kb = lds + krd;
#pragma unroll
        for (int d0 = 0; d0 < 6; ++d0) { const bf16x8 a0 = MLA_LDS(kb + d0 * 32), a1 = MLA_LDS(kb + 32 * MLA_KPITCH + d0 * 32);
            sc0 = MLA_MFMA(a0, qf[d0], d0 == 0 ? negm : sc0); sc1 = MLA_MFMA(a1, qf[d0], d0 == 0 ? negm : sc1); }
    }
    __syncthreads();
    f32x16 o0 = f32x16{}, o1 = f32x16{};
    float mhat = 0.f, lrun = 0.f;
    float mloc = fmaxf(sc0[0], sc1[0]);
#pragma unroll
    for (int r = 1; r < 16; ++r) mloc = fmax3(mloc, sc0[r], sc1[r]);
    for (int t = 0; t < NT; ++t) {
        const bool more_k = (t + 2 < NT), more_v = (t + 1 < NT);
        if (more_k) { const char* kg = Kbh + (size_t)(t + 2) * 64 * 192; rk0 = *(const u32x4*)(kg + kc0 * 16); if (k1) rk1 = *(const u32x4*)(kg + kc1 * 16); }
        if (more_v) rv = *(const u32x4*)(vsrc + (size_t)(t + 1) * 128);
        if (t < NTw) {
            if (t == 0 || __any(mloc > 8.f)) {
                const float rm = fmaxf(mloc, __shfl_xor(mloc, 32));
                const float delta = (t == 0) ? rm : fmaxf(rm, 0.f);
                mhat += delta;
#pragma unroll
                for (int r = 0; r < 16; ++r) { sc0[r] -= delta; sc1[r] -= delta; }
                const float f = __builtin_amdgcn_exp2f(-delta);
                lrun *= f; o0 = o0 * f; o1 = o1 * f;
#pragma unroll
                for (int r = 0; r < 16; ++r) negm[r] = -mhat;
                asm volatile("" : "+v"(negm));
            }
            LAS const unsigned char* kbn = lds + ((t + 1) & 1) * MLA_KBUF + krd;
            LAS const unsigned char* vb = lds + (t & 1) * MLA_VBUF + vrd;
            bf16x8 kc_0 = MLA_LDS(kbn), kc_1 = MLA_LDS(kbn + 32 * MLA_KPITCH), kn_0 = kc_0, kn_1 = kc_1;
            f32x16 sn0, sn1; float la0 = 0.f, la1 = 0.f;
            u32x4 pw0, pw1, pw2, pw3; bf16x8 va_0, va_1, vn_0, vn_1;
            MLA_SBAR();
#pragma unroll
            for (int c = 0; c < 12; ++c) {
                const int d0 = c >> 1, blk = c & 1;
                if (blk == 0 && d0 < 5) { kn_0 = MLA_LDS(kbn + (d0 + 1) * 32); kn_1 = MLA_LDS(kbn + 32 * MLA_KPITCH + (d0 + 1) * 32); }
                if (c == 10) { va_0 = MLA_LDS(vb); va_1 = MLA_LDS(vb + 32 * MLA_VPITCH); }
                if (blk == 0) { if (d0 == 0) sn0 = MLA_MFMA(kc_0, qf[0], negm); else sn0 = MLA_MFMA(kc_0, qf[d0], sn0); }
                else          { if (d0 == 0) sn1 = MLA_MFMA(kc_1, qf[0], negm); else sn1 = MLA_MFMA(kc_1, qf[d0], sn1); }
#pragma unroll
                for (int e = (c * 8 + 2) / 3; e < ((c + 1) * 8 + 2) / 3; ++e) { const float x = __builtin_amdgcn_exp2f(MLA_SC(e));
                    if (e < 16) sc0[e & 15] = x; else sc1[e & 15] = x;
                    if (e & 1) la1 += x; else la0 += x; }
                if (c == 3) { pw0.x = cvtpk(sc0[0], sc0[1]); pw0.y = cvtpk(sc0[2], sc0[3]); pw0.z = cvtpk(sc0[4], sc0[5]); pw0.w = cvtpk(sc0[6], sc0[7]); }
                if (c == 6) { pw1.x = cvtpk(sc0[8], sc0[9]); pw1.y = cvtpk(sc0[10], sc0[11]); pw1.z = cvtpk(sc0[12], sc0[13]); pw1.w = cvtpk(sc0[14], sc0[15]); }
                if (c == 9) { pw2.x = cvtpk(sc1[0], sc1[1]); pw2.y = cvtpk(sc1[2], sc1[3]); pw2.z = cvtpk(sc1[4], sc1[5]); pw2.w = cvtpk(sc1[6], sc1[7]); }
                MLA_SBAR();
                if (blk == 1) { kc_0 = kn_0; kc_1 = kn_1; }
            }
            pw3.x = cvtpk(sc1[8], sc1[9]); pw3.y = cvtpk(sc1[10], sc1[11]); pw3.z = cvtpk(sc1[12], sc1[13]); pw3.w = cvtpk(sc1[14], sc1[15]);
            lrun += la0 + la1;
            float ma = sn0[0], mb = sn1[0];
#pragma unroll
            for (int g = 0; g < 4; ++g) {
                const bf16x8 pf = __builtin_bit_cast(bf16x8, g == 0 ? pw0 : g == 1 ? pw1 : g == 2 ? pw2 : pw3);
                if (g < 3) { vn_0 = MLA_LDS(vb + (g + 1) * 32); vn_1 = MLA_LDS(vb + 32 * MLA_VPITCH + (g + 1) * 32); }
                o0 = MLA_MFMA(va_0, pf, o0);
                ma = fmax3(ma, sn0[4 * g], sn0[4 * g + 1]); mb = fmax3(mb, sn0[4 * g + 2], sn0[4 * g + 3]);
                MLA_SBAR();
                o1 = MLA_MFMA(va_1, pf, o1);
                ma = fmax3(ma, sn1[4 * g], sn1[4 * g + 1]); mb = fmax3(mb, sn1[4 * g + 2], sn1[4 * g + 3]);
                MLA_SBAR();
                va_0 = vn_0; va_1 = vn_1;
            }
            mloc = fmaxf(ma, mb);
            sc0 = sn0; sc1 = sn1;
        }
        if (more_k) { *(LAS u32x4*)(lds + (t & 1) * MLA_KBUF + klds0) = rk0; if (k1) *(LAS u32x4*)(lds + (t & 1) * MLA_KBUF + klds1) = rk1; }
        if (more_v) *(LAS u32x4*)(lds + ((t + 1) & 1) * MLA_VBUF + vlds) = rv;
        __syncthreads();
    }
    const float l = lrun + __shfl_xor(lrun, 32), inv = 1.0f / l;
    const size_t tok = tokbase + q0 + q;
#pragma unroll
    for (int db = 0; db < 2; ++db)
#pragma unroll
        for (int c = 0; c < 4; ++c) { const int d = 32 * db + 8 * c + 4 * hi;
            const u32x2 g = *(const u32x2*)(Gm + tok * 512 + h * 64 + d);
            const f32x16& oo = db == 0 ? o0 : o1;
            u32x2 w; w.x = cvtpk(oo[4 * c] * inv * bflo(g.x), oo[4 * c + 1] * inv * bfhi(g.x)); w.y = cvtpk(oo[4 * c + 2] * inv * bflo(g.y), oo[4 * c + 3] * inv * bfhi(g.y));
            *(u32x2*)(Acat + tok * 1024 + 512 + h * 64 + d) = w; }
}

#define XB_TMO      128
#define XB_XCNT(j)  (256  + 64 * (j))
#define XB_XSUB(j)  (1280 + 64 * (j))
#define XB_XGEN(j)  (2304 + 64 * (j))
#define XB_TOP      3328
#define XB_TOPGEN   3392
#define XCD_BAR_WORDS 3456
#define XB_SPIN_CAP (1u << 18)

__device__ __forceinline__ unsigned xb_ld(unsigned* p)              { return __hip_atomic_load(p, __ATOMIC_RELAXED, __HIP_MEMORY_SCOPE_AGENT); }
__device__ __forceinline__ unsigned xb_add(unsigned* p, unsigned v) { return __hip_atomic_fetch_add(p, v, __ATOMIC_RELAXED, __HIP_MEMORY_SCOPE_AGENT); }
__device__ __forceinline__ unsigned xb_xcc_id() { return (unsigned)__builtin_amdgcn_s_getreg((3 << 11) | 20) & 0xFu; }
#define XB_SPIN(cond, bar) do { unsigned _sp = 0; while (cond) { __builtin_amdgcn_s_sleep(1); \
    if ((++_sp & 255u) == 0u) { if (xb_ld(&(bar)[XB_TMO])) break; if (_sp > XB_SPIN_CAP) { atomicAdd(&(bar)[XB_TMO], 1u); break; } } } } while (0)

struct XcdBarrier {
    unsigned* bar; unsigned x;
    volatile LAS unsigned* st;
};

__device__ __forceinline__ XcdBarrier xcd_barrier_post(unsigned* bar, volatile LAS unsigned* st) {
    XcdBarrier b; b.bar = bar; b.x = xb_xcc_id(); b.st = st;
    if (threadIdx.x == 0) (void)xb_add(&bar[XB_XCNT(b.x)], 1u);
    return b;
}
__device__ __forceinline__ void xcd_barrier_complete(unsigned* bar, unsigned x, unsigned& nloc, unsigned& nx) {
    const unsigned G = gridDim.x * gridDim.y * gridDim.z;
    unsigned sum, cnt, mine, sp = 0u;
    for (;;) {
        sum = 0u; cnt = 0u; mine = 0u;
#pragma unroll
        for (unsigned j = 0; j < 16; ++j) { const unsigned c = xb_ld(&bar[XB_XCNT(j)]); sum += c; cnt += (c > 0u) ? 1u : 0u; mine = (j == x) ? c : mine; }
        if (sum == G) break;
        __builtin_amdgcn_s_sleep(1);
        if ((++sp & 255u) == 0u) { if (xb_ld(&bar[XB_TMO])) break; if (sp > XB_SPIN_CAP) { atomicAdd(&bar[XB_TMO], 1u); break; } }
    }
    nloc = mine > 0u ? mine : 1u; nx = cnt > 0u ? cnt : 1u;
}

__device__ __forceinline__ void xcd_barrier(const XcdBarrier& b) {
    asm volatile("s_waitcnt vmcnt(0)" ::: "memory");
    __syncthreads();
    if (threadIdx.x == 0) {
        unsigned* bar = b.bar;
        __builtin_amdgcn_s_waitcnt(0);
        unsigned nloc = b.st[0], nx = b.st[1];
        if (nloc == 0u) { xcd_barrier_complete(bar, b.x, nloc, nx); b.st[0] = nloc; b.st[1] = nx; }
        const unsigned old = xb_add(&bar[XB_XSUB(b.x)], 1u);
        const unsigned gen = old / nloc;
        if (old + 1u == (gen + 1u) * nloc) {
            __builtin_amdgcn_fence(__ATOMIC_RELEASE, "agent");
            asm volatile("s_waitcnt vmcnt(0)" ::: "memory");
            const unsigned og = xb_add(&bar[XB_TOP], 1u);
            const unsigned tg = og / nx;
            if (og + 1u == (tg + 1u) * nx) xb_add(&bar[XB_TOPGEN], 1u);
            else XB_SPIN(xb_ld(&bar[XB_TOPGEN]) == tg, bar);
            __builtin_amdgcn_fence(__ATOMIC_ACQUIRE, "agent");
            xb_add(&bar[XB_XGEN(b.x)], 1u);
            asm volatile("s_waitcnt vmcnt(0)" ::: "memory");
        } else {
            XB_SPIN(xb_ld(&bar[XB_XGEN(b.x)]) == gen, bar);
            __builtin_amdgcn_fence(__ATOMIC_ACQUIRE, "agent");
            asm volatile("s_waitcnt vmcnt(0)" ::: "memory");
        }
    }
    __syncthreads();
}

struct Args { const float* in[12]; float* out; unsigned char* ws; int ph_lo, ph_hi; };

__global__ void __launch_bounds__(NTHREADS, 2) fwd_kernel(Args args) {
    extern __shared__ __attribute__((aligned(16))) unsigned char lds_raw[];
    LAS unsigned char* lds = (LAS unsigned char*)lds_raw;
    const int tid = threadIdx.x, lane = tid & 63, wave = __builtin_amdgcn_readfirstlane(tid >> 6);
    const int G = gridDim.x, bx = blockIdx.x;
    const int vcu = (G % 8 == 0) ? (bx % 8) * (G / 8) + bx / 8 : bx;
    const int gw = vcu * NWAVES + wave, NGW = G * NWAVES;
    unsigned char* ws = args.ws;
    const float* x = args.in[0];
    float* rowsq = (float*)(ws + WS_ROWSQ); float* cosT = (float*)(ws + WS_COS); float* sinT = (float*)(ws + WS_SIN);
    bf16 *Bt1 = (bf16*)(ws + WS_BT1), *Bt2a = (bf16*)(ws + WS_BT2A), *Bt2b = (bf16*)(ws + WS_BT2B), *Bt2c = (bf16*)(ws + WS_BT2C), *Bt4 = (bf16*)(ws + WS_BT4), *Bt5 = (bf16*)(ws + WS_BT5);
    float* Krope = (float*)(ws + WS_KROPE);
    bf16 *H = (bf16*)(ws + WS_H), *Acat = (bf16*)(ws + WS_ACAT), *Qsb = (bf16*)(ws + WS_QSB), *Ksb = (bf16*)(ws + WS_KSB), *VtSb = (bf16*)(ws + WS_VTSB), *Gsb = (bf16*)(ws + WS_GSB), *Merged = (bf16*)(ws + WS_MERGED);
    bf16 *Gmla = (bf16*)(ws + WS_GMLA), *Cq = (bf16*)(ws + WS_CQ), *Ckv = (bf16*)(ws + WS_CKV), *Cqn = (bf16*)(ws + WS_CQN), *Ckvn = (bf16*)(ws + WS_CKVN);
    bf16 *Qm = (bf16*)(ws + WS_QM), *Km = (bf16*)(ws + WS_KM), *VtM = (bf16*)(ws + WS_VTM);
    bf16* Gg = (bf16*)(ws + WS_G);
    const int lo = args.ph_lo, hi = args.ph_hi;
#ifndef PHMASK
#define PHMASK 0xff
#endif
#ifdef DBG_PROBE
#define IN(k) ((k) <= DBG_PROBE && lo <= (k) && (k) < hi)
#else
#define IN(k) (((PHMASK >> (k)) & 1) && lo <= (k) && (k) < hi)
#endif
#ifndef REP_SYNC
#define REP_SYNC 1
#endif
#define SEAM(k) do { if (IN(k) && IN((k) + 1)) { xcd_barrier(bar); if ((k) == 2) for (int rep_ = 1; rep_ < REP_SYNC; ++rep_) xcd_barrier(bar); } } while (0)
    volatile LAS unsigned* MISC = (volatile LAS unsigned*)(lds + 131072 + 512);
    if (tid < 32) MISC[tid] = 0u;
    __syncthreads();
    XcdBarrier bar; bar.bar = (unsigned*)(ws + WS_BAR); bar.x = 0; bar.st = nullptr;
    if (hi - lo > 1) bar = xcd_barrier_post((unsigned*)(ws + WS_BAR), MISC + 8);
    if (lo < 0) cg::this_grid().sync();

#ifndef REP_P0
#define REP_P0 1
#endif
    if (IN(0)) for (int rep = 0; rep < REP_P0; ++rep) {
        const int gt = vcu * NTHREADS + tid, NGT = G * NTHREADS;
        for (int i = gt; i < M; i += NGT) rowsq[i] = 0.f;
        for (int i = gt; i < SEQ * 16; i += NGT) { const int pos = i >> 4, k = i & 15;
            const float inv_freq = (float)pow(10000.0, -(double)k / 16.0);
            const float ang = (float)pos * inv_freq;
            const double rev = (double)ang * 0.15915494309189535; const float fr = (float)(rev - rint(rev));
            cosT[i] = __builtin_amdgcn_cosf(fr); sinT[i] = __builtin_amdgcn_sinf(fr); }
        LAS float* scr = (LAS float*)(lds + wave * 16384);
        constexpr int I1 = 16 * (N1 / 32), I2A = 6 * 24, I2B = 4 * 16, I2C = 4 * 16, I4A = 8 * 32, I4B = 8 * 32, I5 = 16 * 32;
        constexpr int NITEMS = I1 + I2A + I2B + I2C + I4A + I4B + I5;
        for (int it = gw; it < NITEMS; it += NGW) {
            int r = it;
            if (r < I1) { p0_transpose_item<1>(args.in[2], IN_COLS, Bt1, 1024, 0, N1 / 32, scr, r, lane); continue; } r -= I1;
            if (r < I2A) { p0_transpose_item<2>(args.in[5], 768, Bt2a, 384, 0, 24, scr, r, lane); continue; } r -= I2A;
            if (r < I2B) { p0_transpose_item<3>(args.in[7], 1024, Bt2b, 256, 0, 16, scr, r, lane); continue; } r -= I2B;
            if (r < I2C) { p0_transpose_item<4>(args.in[7], 1024, Bt2c, 256, 0, 16, scr, r, lane); continue; } r -= I2C;
            if (r < I4A) { p0_transpose_item<0>(args.in[8], 1024, Bt4, 1024, 0, 32, scr, r, lane); continue; } r -= I4A;
            if (r < I4B) { p0_transpose_item<0>(args.in[9], 1024, Bt4, 1024, 512, 32, scr, r, lane); continue; } r -= I4B;
            p0_transpose_item<0>(args.in[10], 1024, Bt5, 1024, 0, 32, scr, r, lane);
        }
        const float* gin = args.in[1];
        f32x4 gv[4];
#pragma unroll
        for (int j = 0; j < 4; ++j) gv[j] = *(const f32x4*)(gin + 256 * j + 4 * lane);
        for (int m = gw; m < M; m += NGW) {
            const f32x4* xr = (const f32x4*)(x + (size_t)m * DM) + lane;
            f32x4 v[4]; float s = 0.f;
#pragma unroll
            for (int j = 0; j < 4; ++j) { v[j] = xr[64 * j]; s += (v[j].x * v[j].x + v[j].y * v[j].y) + (v[j].z * v[j].z + v[j].w * v[j].w); }
            const float inv = 1.0f / sqrtf(wave_sum(s) * (1.f / DM) + EPS);
            u32x2* o8 = (u32x2*)(H + (size_t)m * DM) + lane;
#pragma unroll
            for (int j = 0; j < 4; ++j) { u32x2 w; w.x = cvtpk(v[j].x * inv * gv[j].x, v[j].y * inv * gv[j].y); w.y = cvtpk(v[j].z * inv * gv[j].z, v[j].w * inv * gv[j].w); o8[64 * j] = w; }
        }
    }
    SEAM(0);

#ifndef REP_P1
#define REP_P1 1
#endif
    if (IN(1)) for (int rep = 0; rep < REP_P1; ++rep) {
        { pg8::Gemm g{H, Bt1, M, N1A, DM}; pg8::StaticOrder S; S.init(M, N1A, G, bx);
          pg8::Epi1 E{Qsb, Ksb, Gsb, Cq, Ckv, Gmla, Gg, Krope, args.in[3]};
          pg8::gemm_phase<pg8::Epi1, pg8::StaticOrder, true, true>(lds, g, S, E); }
        { pg8::Gemm g{Bt1 + (size_t)N1A * DM, H, 512, M, DM}; pg8::StaticOrder S; S.init(512, M, G, (bx + G - 192 % G) % G);
          pg8::EpiPlain E{VtSb, M};
          pg8::gemm_phase<pg8::EpiPlain, pg8::StaticOrder, true, true>(lds, g, S, E); }
    }
    SEAM(1);

#ifndef REP_P2
#define REP_P2 1
#endif
    if (IN(2)) for (int rep = 0; rep < REP_P2; ++rep) {
        const float* gq = args.in[4]; const float* gkv = args.in[6];
        float gqa[3], gqb[3], gka[2], gkb[2];
#pragma unroll
        for (int i = 0; i < 3; ++i) { gqa[i] = gq[128 * i + 2 * lane]; gqb[i] = gq[128 * i + 2 * lane + 1]; }
#pragma unroll
        for (int i = 0; i < 2; ++i) { gka[i] = gkv[128 * i + 2 * lane]; gkb[i] = gkv[128 * i + 2 * lane + 1]; }
        for (int m = gw; m < M; m += NGW) {
            const int b = m >> 13, s = m & 8191;
            const unsigned* cq = (const unsigned*)(Cq + (size_t)m * 384) + lane; unsigned w[3]; float ss = 0.f;
#pragma unroll
            for (int i = 0; i < 3; ++i) { w[i] = cq[64 * i]; const float a = bflo(w[i]), c = bfhi(w[i]); ss += a * a + c * c; }
            float inv = 1.0f / sqrtf(wave_sum(ss) * (1.f / 384.f) + EPS);
            unsigned* oq = (unsigned*)(Cqn + (size_t)m * 384) + lane;
#pragma unroll
            for (int i = 0; i < 3; ++i) oq[64 * i] = cvtpk(bflo(w[i]) * inv * gqa[i], bfhi(w[i]) * inv * gqb[i]);
            const unsigned* ck = (const unsigned*)(Ckv + (size_t)m * 256) + lane; unsigned wk[2]; ss = 0.f;
#pragma unroll
            for (int i = 0; i < 2; ++i) { wk[i] = ck[64 * i]; const float a = bflo(wk[i]), c = bfhi(wk[i]); ss += a * a + c * c; }
            inv = 1.0f / sqrtf(wave_sum(ss) * (1.f / 256.f) + EPS);
            unsigned* ok = (unsigned*)(Ckvn + (size_t)m * 256) + lane;
#pragma unroll
            for (int i = 0; i < 2; ++i) ok[64 * i] = cvtpk(bflo(wk[i]) * inv * gka[i], bfhi(wk[i]) * inv * gkb[i]);
            const int hh = lane >> 3, jj = lane & 7;
            const f32x2 x1 = *(const f32x2*)(Krope + (size_t)m * 32 + 2 * jj), x2 = *(const f32x2*)(Krope + (size_t)m * 32 + 16 + 2 * jj);
            const f32x2 c2 = *(const f32x2*)(cosT + s * 16 + 2 * jj), s2 = *(const f32x2*)(sinT + s * 16 + 2 * jj);
            const f32x2 o1 = x1 * c2 - x2 * s2, o2 = x1 * s2 + x2 * c2;
            bf16* kd = Km + ((size_t)((b * 8 + hh) * SEQ + s)) * 96 + 64 + 2 * jj;
            *(unsigned*)kd = cvtpk(o1.x, o1.y); *(unsigned*)(kd + 16) = cvtpk(o2.x, o2.y);
        }
    }
    SEAM(2);

#ifndef REP_P3
#define REP_P3 1
#endif
    if (IN(3)) for (int rep = 0; rep < REP_P3; ++rep) {
        { pg8::Gemm g{Cqn, Bt2a, M, 768, 384}; pg8::StaticOrder S; S.init(M, 768, G, bx);
          pg8::Epi2a E{Qm, cosT, sinT, 0.10206207261596577f * L2E};
          pg8::gemm_phase<pg8::Epi2a, pg8::StaticOrder, true, true>(lds, g, S, E); }
        { pg8::Gemm g{Ckvn, Bt2b, M, 512, 256}; pg8::StaticOrder S; S.init(M, 512, G, (bx + G - 192 % G) % G);
          pg8::Epi2b E{Km};
          pg8::gemm_phase<pg8::Epi2b, pg8::StaticOrder, true, true>(lds, g, S, E); }
        { pg8::Gemm g{Bt2c, Ckvn, 512, M, 256}; pg8::StaticOrder S; S.init(512, M, G, (bx + G - 64 % G) % G);
          pg8::EpiPlain E{VtM, M};
          pg8::gemm_phase<pg8::EpiPlain, pg8::StaticOrder, true, true>(lds, g, S, E); }
    }
    SEAM(3);

    if (IN(4)) {
#ifndef REP_SB
#define REP_SB 1
#endif
#ifndef REP_MLA
#define REP_MLA 1
#endif
        for (int rep = 0; rep < REP_SB; ++rep)
        for (int task = gw; task < 16 * 256; task += NGW) { const int bh = task >> 8, j = task & 255; sb_task(bh >> 3, bh & 7, j, Qsb, Ksb, VtSb, Gsb, Acat, lane); }
        __syncthreads();
        for (int rep = 0; rep < REP_MLA; ++rep)
        for (int p = vcu; p < 256; p += G) { const int bh = p >> 4, sx = p & 15;
            mla_unit(bh >> 3, bh & 7, 31 - sx, Qm, Km, VtM, Gmla, Acat, lds);
            mla_unit(bh >> 3, bh & 7, sx, Qm, Km, VtM, Gmla, Acat, lds); }
    }
    SEAM(4);

#ifndef REP_P5
#define REP_P5 1
#endif
    if (IN(5)) for (int rep = 0; rep < REP_P5; ++rep) {
        pg8::Gemm g{Acat, Bt4, M, DM, DM}; pg8::StaticOrder S; S.init(M, DM, G, bx);
        pg8::Epi4 E{Gg, Merged};
        pg8::gemm_phase<pg8::Epi4, pg8::StaticOrder, true, true>(lds, g, S, E);
    }
    SEAM(5);

#ifndef REP_P6
#define REP_P6 1
#endif
    if (IN(6)) for (int rep = 0; rep < REP_P6; ++rep) {
        pg8::Gemm g{Merged, Bt5, M, DM, DM}; pg8::StaticOrder S; S.init(M, DM, G, bx);
        pg8::Epi5 E{x, args.out, rowsq};
        pg8::gemm_phase<pg8::Epi5, pg8::StaticOrder, true, true>(lds, g, S, E);
    }
    SEAM(6);

#ifdef DBG_PROBE
    if (lo <= 7 && 7 < hi) {
        const int gt = vcu * NTHREADS + tid, NGT = G * NTHREADS;
        for (size_t i = gt; i < (size_t)M * DM; i += NGT) {
            float v = 0.f;
#if DBG_PROBE == 3
            v += bflo(Qsb[i % ((size_t)M * 512)]) + bflo(Ksb[i % ((size_t)M * 512)]) * 2.f + bflo(VtSb[i % ((size_t)M * 512)]) * 3.f + bflo(Gsb[i % ((size_t)M * 512)]) * 4.f + bflo(Gmla[i % ((size_t)M * 512)]) * 5.f;
            v += bflo(Qm[i % ((size_t)M * 768)]) * 6.f + bflo(Km[i % ((size_t)M * 768)]) * 7.f + bflo(VtM[i % ((size_t)M * 512)]) * 8.f;
#elif DBG_PROBE == 1
            { const unsigned w = ((const unsigned*)Gg)[i]; v = bflo(w) + 3.f * bfhi(w); }
#elif DBG_PROBE == 4
            v += bflo(Acat[i]);
#elif DBG_PROBE == 5
            v += bflo(Merged[i]);
#endif
            args.out[i] = v;
        }
    }
#else
    if (IN(7)) {
        const float* gf = args.in[11];
        f32x4 gv[4];
#pragma unroll
        for (int j = 0; j < 4; ++j) gv[j] = *(const f32x4*)(gf + 256 * j + 4 * lane);
        for (int m = gw; m < M; m += NGW) {
            const float inv = 1.0f / sqrtf(rowsq[m] * (1.f / DM) + EPS);
            f32x4* xr = (f32x4*)(args.out + (size_t)m * DM) + lane;
#pragma unroll
#ifndef REP_P7
#define REP_P7 1
#endif
            for (int rep = 1; rep < REP_P7; ++rep) { _Pragma("unroll") for (int j = 0; j < 4; ++j) { f32x4 v = xr[64 * j]; asm volatile("" : "+v"(v)); xr[64 * j] = v; } }
            for (int j = 0; j < 4; ++j) { f32x4 v = xr[64 * j]; v = v * inv * gv[j]; xr[64 * j] = v; }
        }
    }
#endif
#undef IN
#undef SEAM
}

extern "C" void kernel_launch(void* const* d_in, const int* in_sizes, int n_in, void* d_out, int out_size, void* d_ws, size_t ws_size, hipStream_t stream) {
    static int grid = 0;
    if (grid == 0) {
        if (n_in != 12 || in_sizes[0] != M * DM || out_size != M * DM || ws_size < WS_END) { fprintf(stderr, "kernel_launch: unexpected shapes (n_in %d, in0 %d, out %d, ws %zu)\n", n_in, n_in > 0 ? in_sizes[0] : -1, out_size, ws_size); grid = -1; return; }
        int dev = 0, cus = 0, per_cu = 0;
        if (hipGetDevice(&dev) != hipSuccess || hipDeviceGetAttribute(&cus, hipDeviceAttributeMultiprocessorCount, dev) != hipSuccess) { grid = -1; return; }
        if (hipFuncSetAttribute((const void*)fwd_kernel, hipFuncAttributeMaxDynamicSharedMemorySize, LDS_BYTES) != hipSuccess) { fprintf(stderr, "kernel_launch: hipFuncSetAttribute failed\n"); grid = -1; return; }
        if (hipOccupancyMaxActiveBlocksPerMultiprocessor(&per_cu, (const void*)fwd_kernel, NTHREADS, LDS_BYTES) != hipSuccess || per_cu < 1) { fprintf(stderr, "kernel_launch: occupancy query says %d\n", per_cu); per_cu = 1; }
        (void)hipGetLastError();
        grid = cus * 1;
    }
    if (grid < 0) return;
    Args a{};
    for (int i = 0; i < 12; ++i) a.in[i] = (const float*)d_in[i];
    a.out = (float*)d_out; a.ws = (unsigned char*)d_ws;
#if MK_N_LAUNCHES == 1
    a.ph_lo = 0; a.ph_hi = N_PHASES;
    if (hipMemsetAsync((char*)d_ws + WS_BAR, 0, BAR_ZERO_BYTES, stream) != hipSuccess) { fprintf(stderr, "kernel_launch: hipMemsetAsync failed\n"); return; }
    void* kargs[] = {&a};
    hipError_t e = hipLaunchCooperativeKernel((const void*)fwd_kernel, dim3(grid), dim3(NTHREADS), kargs, LDS_BYTES, stream);
    if (e != hipSuccess) fprintf(stderr, "kernel_launch: cooperative launch failed: %s (grid %d)\n", hipGetErrorString(e), grid);
#else
    for (int p = 0; p < N_PHASES; ++p) { a.ph_lo = p; a.ph_hi = p + 1;
        hipLaunchKernelGGL(fwd_kernel, dim3(grid), dim3(NTHREADS), LDS_BYTES, stream, a);
        const hipError_t le = hipPeekAtLastError();
        if (le != hipSuccess) { fprintf(stderr, "kernel_launch: launch %d failed: %s\n", p, hipGetErrorName(le)); break; } }
#endif
}
```
